# Optimizing an MI355X kernel written in HIP

```python
import math
import jax, jax.numpy as jnp
from jax import lax
import numpy as np

D_MODEL = 2048
BATCH = 2
SEQ = 4096
DEPTH = 1
DEC_BATCH = 4
DEC_SEQ = 8192
PAST_LEN = 128

GRID_W = 64
D_ATTN = D_MODEL // 2
D_HYENA = D_MODEL - D_ATTN
HEAD_DIM = 128
N_Q_HEADS = D_ATTN // HEAD_DIM
N_KV_HEADS = 2
Q_PER_KV = N_Q_HEADS // N_KV_HEADS
ROPE_HALF = HEAD_DIM // 2
ROPE_THETA = 10000.0
Q_BLOCK = 128
HYENA_ORDER = 2
SHORT_CONV = 3
FILTER_EMB = 33
FILTER_HIDDEN = 64
DECAY_MIN = -math.log(1e-2) / 1.5
DECAY_MAX = -math.log(1e-2) / 0.3
D_FF = 5632
EPS = 1e-6
D_KV = N_KV_HEADS * HEAD_DIM
D_IN_PROJ = D_ATTN + 2 * D_KV + (HYENA_ORDER + 1) * D_HYENA

kernel_name = "hybrid_attn_hyena_macaron_encoder"


def rmsnorm(x, g):
    xf = x.astype(jnp.float32)
    y = xf * lax.rsqrt(jnp.mean(xf * xf, axis=-1, keepdims=True) + EPS)
    return (y * g.astype(jnp.float32)).astype(x.dtype)


def swiglu(h, w13, w2):
    gate, up = jnp.split(h @ w13, 2, axis=-1)
    return (jax.nn.silu(gate) * up) @ w2


def axial_rope_tables(L):
    rows = L // GRID_W
    row = jnp.repeat(jnp.arange(rows, dtype=jnp.float32), GRID_W)
    col = jnp.tile(jnp.arange(GRID_W, dtype=jnp.float32), rows)
    inv = ROPE_THETA ** (-jnp.arange(0, ROPE_HALF, 2, dtype=jnp.float32) / ROPE_HALF)
    ang_r = row[:, None] * inv[None]
    ang_c = col[:, None] * inv[None]
    return jnp.cos(ang_r), jnp.sin(ang_r), jnp.cos(ang_c), jnp.sin(ang_c)


def rotate(x, cos, sin):
    x1, x2 = jnp.split(x, 2, axis=-1)
    c = cos[None, :, None, :]
    s = sin[None, :, None, :]
    return jnp.concatenate([x1 * c - x2 * s, x2 * c + x1 * s], axis=-1)


def apply_axial_rope(x, tabs):
    cr, sr, cc, sc = tabs
    xf = x.astype(jnp.float32)
    out = jnp.concatenate([rotate(xf[..., :ROPE_HALF], cr, sr),
                           rotate(xf[..., ROPE_HALF:], cc, sc)], axis=-1)
    return out.astype(x.dtype)


def block_attention(q, k, v):
    B, L, _, _ = q.shape
    nb = L // Q_BLOCK
    qb = q.reshape(B, nb, Q_BLOCK, N_KV_HEADS, Q_PER_KV, HEAD_DIM).transpose(1, 0, 2, 3, 4, 5)

    def one_block(qi):
        s = jnp.einsum('bqkgd,bskd->bkgqs', qi, k).astype(jnp.float32)
        p = jax.nn.softmax(s, axis=-1).astype(v.dtype)
        return jnp.einsum('bkgqs,bskd->bqkgd', p, v)

    o = lax.map(one_block, qb)
    return o.transpose(1, 0, 2, 3, 4, 5).reshape(B, L, N_Q_HEADS * HEAD_DIM)


def short_conv(x, w, b):
    xp = jnp.pad(x, ((0, 0), (1, 1), (0, 0)))
    return xp[:, :-2] * w[0] + xp[:, 1:-1] * w[1] + xp[:, 2:] * w[2] + b


def hyena_filters(L, w1, b1, w2, b2, w3, freq, decay):
    f32 = jnp.float32
    t01 = jnp.linspace(0.0, 1.0, L, dtype=f32)[:, None]
    bands = (FILTER_EMB - 1) // 2
    fr = jnp.linspace(1e-4, bands - 1, bands, dtype=f32)[None]
    w = 2.0 * math.pi * jnp.arange(L, dtype=f32)[:, None] / L
    feats = jnp.concatenate([t01, jnp.cos(fr * w), -jnp.sin(fr * w)], axis=-1)
    fq = freq.astype(f32)
    h = jnp.sin(fq * (feats @ w1.astype(f32) + b1.astype(f32)))
    h = jnp.sin(fq * (h @ w2.astype(f32) + b2.astype(f32)))
    h = (h @ w3.astype(f32)).reshape(L, 2, HYENA_ORDER, D_HYENA)
    h = h * jnp.exp(-t01[:, :, None, None] * jnp.abs(decay.astype(f32))[None])
    fwd, bwd = h[:, 0], h[:, 1]
    kfull = jnp.concatenate([fwd, jnp.zeros((1, HYENA_ORDER, D_HYENA), f32), bwd[1:][::-1]], axis=0)
    return kfull / jnp.sum(jnp.abs(kfull), axis=0, keepdims=True)


def fftconv(z, kf, d):
    L = z.shape[1]
    zf = z.astype(jnp.float32)
    Z = jnp.fft.rfft(zf, n=2 * L, axis=1)
    K = jnp.fft.rfft(kf, axis=0)
    y = jnp.fft.irfft(Z * K[None], n=2 * L, axis=1)[:, :L]
    return (y + zf * d.astype(jnp.float32)).astype(z.dtype)


def encoder_layer(x, ffn1_norm, ffn1_w13, ffn1_w2, mix_norm, w_in, q_norm, k_norm,
                  conv_w, conv_b, filt_w1, filt_b1, filt_w2, filt_b2, filt_w3, filt_freq,
                  hyena_decay, hyena_bias, group_out_norm, w_out,
                  ffn2_norm, ffn2_w13, ffn2_w2):
    B, L, _ = x.shape
    x = x + 0.5 * swiglu(rmsnorm(x, ffn1_norm), ffn1_w13, ffn1_w2)
    h = rmsnorm(x, mix_norm)
    p = h @ w_in
    q = p[..., :D_ATTN].reshape(B, L, N_Q_HEADS, HEAD_DIM)
    k = p[..., D_ATTN:D_ATTN + D_KV].reshape(B, L, N_KV_HEADS, HEAD_DIM)
    v = p[..., D_ATTN + D_KV:D_ATTN + 2 * D_KV].reshape(B, L, N_KV_HEADS, HEAD_DIM)
    hy = p[..., D_ATTN + 2 * D_KV:]
    tabs = axial_rope_tables(L)
    q = apply_axial_rope(rmsnorm(q, q_norm), tabs) * (HEAD_DIM ** -0.5)
    k = apply_axial_rope(rmsnorm(k, k_norm), tabs)
    attn_out = block_attention(q, k, v)
    hy = short_conv(hy, conv_w, conv_b)
    hv, hx1, hx2 = jnp.split(hy, 3, axis=-1)
    kf = hyena_filters(L, filt_w1, filt_b1, filt_w2, filt_b2, filt_w3, filt_freq, hyena_decay)
    z = hx1 * fftconv(hv, kf[:, 0], hyena_bias[0])
    hyena_out = hx2 * fftconv(z, kf[:, 1], hyena_bias[1])
    merged = jnp.concatenate([rmsnorm(attn_out, group_out_norm[:D_ATTN]),
                              rmsnorm(hyena_out, group_out_norm[D_ATTN:])], axis=-1)
    x = x + merged @ w_out
    x = x + 0.5 * swiglu(rmsnorm(x, ffn2_norm), ffn2_w13, ffn2_w2)
    return x


def setup_inputs(seed: int = 0) -> dict:
    key = jax.random.key(seed)
    ks = jax.random.split(key, 32)
    f32 = jnp.float32

    def nrm(k, shape, scale):
        return jax.random.normal(k, shape, f32) * scale

    def gain(k, shape):
        return 1.0 + 0.02 * jax.random.normal(k, shape, f32)

    rates = jnp.linspace(DECAY_MIN, DECAY_MAX, D_HYENA, dtype=f32)
    return {
        "x_prompt": jax.random.normal(ks[0], (BATCH, SEQ, D_MODEL), f32),
        "x_sample": jax.random.normal(ks[1], (DEC_BATCH, DEC_SEQ, D_MODEL), f32),
        "ffn1_norm": gain(ks[2], (DEPTH, D_MODEL)),
        "ffn1_w13": nrm(ks[3], (DEPTH, D_MODEL, 2 * D_FF), D_MODEL ** -0.5),
        "ffn1_w2": nrm(ks[4], (DEPTH, D_FF, D_MODEL), D_FF ** -0.5),
        "mix_norm": gain(ks[5], (DEPTH, D_MODEL)),
        "w_in": nrm(ks[6], (DEPTH, D_MODEL, D_IN_PROJ), D_MODEL ** -0.5),
        "q_norm": gain(ks[7], (DEPTH, HEAD_DIM)),
        "k_norm": gain(ks[8], (DEPTH, HEAD_DIM)),
        "conv_w": nrm(ks[9], (DEPTH, SHORT_CONV, 3 * D_HYENA), SHORT_CONV ** -0.5),
        "conv_b": nrm(ks[10], (DEPTH, 3 * D_HYENA), 0.02),
        "filt_w1": nrm(ks[11], (DEPTH, FILTER_EMB, FILTER_HIDDEN), FILTER_EMB ** -0.5),
        "filt_b1": nrm(ks[12], (DEPTH, FILTER_HIDDEN), 0.1),
        "filt_w2": nrm(ks[13], (DEPTH, FILTER_HIDDEN, FILTER_HIDDEN), FILTER_HIDDEN ** -0.5),
        "filt_b2": nrm(ks[14], (DEPTH, FILTER_HIDDEN), 0.1),
        "filt_w3": nrm(ks[15], (DEPTH, FILTER_HIDDEN, 2 * HYENA_ORDER * D_HYENA), FILTER_HIDDEN ** -0.5),
        "filt_freq": gain(ks[16], (DEPTH, FILTER_HIDDEN)),
        "hyena_decay": rates[None, None, None, :] * (1.0 + 0.05 * jax.random.normal(ks[17], (DEPTH, 2, HYENA_ORDER, D_HYENA), f32)),
        "hyena_bias": nrm(ks[18], (DEPTH, HYENA_ORDER, D_HYENA), 1.0),
        "group_out_norm": gain(ks[19], (DEPTH, D_MODEL)),
        "w_out": nrm(ks[20], (DEPTH, D_MODEL, D_MODEL), D_MODEL ** -0.5),
        "ffn2_norm": gain(ks[21], (DEPTH, D_MODEL)),
        "ffn2_w13": nrm(ks[22], (DEPTH, D_MODEL, 2 * D_FF), D_MODEL ** -0.5),
        "ffn2_w2": nrm(ks[23], (DEPTH, D_FF, D_MODEL), D_FF ** -0.5),
        "final_norm": gain(ks[24], (D_MODEL,)),
    }


def reference(x_prompt, x_sample, ffn1_norm, ffn1_w13, ffn1_w2, mix_norm, w_in, q_norm, k_norm,
              conv_w, conv_b, filt_w1, filt_b1, filt_w2, filt_b2, filt_w3, filt_freq,
              hyena_decay, hyena_bias, group_out_norm, w_out,
              ffn2_norm, ffn2_w13, ffn2_w2, final_norm):
    def trunk(x):
        for i in range(DEPTH):
            x = encoder_layer(x, ffn1_norm[i], ffn1_w13[i], ffn1_w2[i], mix_norm[i], w_in[i],
                              q_norm[i], k_norm[i], conv_w[i], conv_b[i],
                              filt_w1[i], filt_b1[i], filt_w2[i], filt_b2[i], filt_w3[i], filt_freq[i],
                              hyena_decay[i], hyena_bias[i], group_out_norm[i], w_out[i],
                              ffn2_norm[i], ffn2_w13[i], ffn2_w2[i])
        return rmsnorm(x, final_norm)

    y_prompt = trunk(x_prompt)
    y_sample = trunk(x_sample)
    return (y_prompt, y_sample)
```

```cpp
#include <hip/hip_runtime.h>
#include <hip/hip_bf16.h>
#include <hip/hip_cooperative_groups.h>
#include <cstdio>
#include <cstdint>
#include <cmath>
namespace cg = cooperative_groups;
#ifndef MK_ONE_LAUNCH
#define MK_ONE_LAUNCH 1
#endif
namespace pg8 {
#define PG8_LAS __attribute__((address_space(3)))
typedef unsigned short bf16_t;
typedef short bf16x8 __attribute__((ext_vector_type(8)));
typedef float f32x4 __attribute__((ext_vector_type(4)));
typedef unsigned u32x4 __attribute__((ext_vector_type(4)));
constexpr int BM = 256, BK = 64, HALF = 128, HTB = HALF * BK * 2  , STAGE_BYTES = 8 * HTB, NXCD = 8, WGM = 8;

__host__ __device__ __forceinline__ int lds_byte(int r, int c) { const int st = (r >> 4) * 2 + (c >> 5), rr = r & 15, cc = c & 31, ob = rr * 64 + cc * 2; return st * 1024 + (ob ^ (((ob >> 9) & 1) << 5)); }
__host__ __device__ __forceinline__ void stage_rc(int b, int& R, int& C) { const int st = b / 1024, sb = b % 1024, swz = sb ^ (((sb >> 9) & 1) << 5); R = (st >> 1) * 16 + swz / 64; C = (st & 1) * 32 + (swz % 64) / 2; }
__host__ __device__ __forceinline__ int perm32(int rho) { const int n = rho >> 4, i = rho & 15; return 8 * (i >> 2) + 4 * n + (i & 3); }

struct Unit { int pm, pn; };
struct Gemm { const bf16_t* A; const bf16_t* Bt; int M, N, K; };

struct StaticOrder {
    int nM, nN, nwg, G, c;
    __host__ __device__ void init(int M, int N, int G_, int c_) { nM = M / BM; nN = N / BM; nwg = nM * nN; G = G_; c = c_; }
    __host__ __device__ bool next(int i, Unit& u) const {
        const long L = (long)i * G + c; if (L >= nwg) return false;
        int wgid = (int)L; { const int q = nwg / NXCD, r = nwg % NXCD, xcd = wgid % NXCD, off = wgid / NXCD; wgid = (xcd < r ? xcd * (q + 1) : r * (q + 1) + (xcd - r) * q) + off; }
        const int nig = WGM * nN, gid = wgid / nig, fm = gid * WGM, gsz = (nM - fm) < WGM ? (nM - fm) : WGM;
        u.pm = fm + ((wgid % nig) % gsz); u.pn = (wgid % nig) / gsz; return true;
    }
    __device__ __forceinline__ void a_ready(const Unit&) const {}
    __device__ __forceinline__ void done(const Unit&) const {}
};
__device__ __forceinline__ unsigned cvt_pk_bf16(float lo, float hi) { unsigned r; asm volatile("v_cvt_pk_bf16_f32 %0, %1, %2" : "=v"(r) : "v"(lo), "v"(hi)); return r; }
typedef float f32x2 __attribute__((ext_vector_type(2)));
__device__ __forceinline__ float silu_f(float x) { return x * __builtin_amdgcn_rcpf(1.0f + __builtin_amdgcn_exp2f(-1.4426950408889634f * x)); }
struct EpiBf16 {
    static constexpr bool PERM = true, AFTER_DRAIN = false;
    bf16_t* O; int ldc;
    __device__ __forceinline__ void operator()(const f32x4 (&acc)[2][2][4][2], const Unit& u, int wr, int wc, int fr, int fq) const {
        const int row0 = u.pm * BM + wr * 64 + fr; const int col0 = u.pn * BM + wc * 32 + 8 * fq;
#pragma unroll
        for (int ai = 0; ai < 2; ++ai)
#pragma unroll
            for (int m = 0; m < 4; ++m) { bf16_t* rowp = O + (size_t)(row0 + ai * HALF + m * 16) * ldc + col0;
#pragma unroll
                for (int bj = 0; bj < 2; ++bj) { const f32x4 v0 = acc[ai][bj][m][0], v1 = acc[ai][bj][m][1];
                    u32x4 w; w.x = cvt_pk_bf16(v0[0], v0[1]); w.y = cvt_pk_bf16(v0[2], v0[3]); w.z = cvt_pk_bf16(v1[0], v1[1]); w.w = cvt_pk_bf16(v1[2], v1[3]);
                    *(u32x4*)(rowp + bj * HALF) = w; } }
    }
};
struct EpiSwiGLU {
    static constexpr bool PERM = true, AFTER_DRAIN = false;
    bf16_t* O; int ldc;
    __device__ __forceinline__ void operator()(const f32x4 (&acc)[2][2][4][2], const Unit& u, int wr, int wc, int fr, int fq) const {
        const int row0 = u.pm * BM + wr * 64 + fr; const int col0 = u.pn * HALF + wc * 32 + 8 * fq;
#pragma unroll
        for (int ai = 0; ai < 2; ++ai)
#pragma unroll
            for (int m = 0; m < 4; ++m) { bf16_t* rowp = O + (size_t)(row0 + ai * HALF + m * 16) * ldc + col0;
                const f32x4 g0 = acc[ai][0][m][0], g1 = acc[ai][0][m][1], u0 = acc[ai][1][m][0], u1 = acc[ai][1][m][1];
                u32x4 w;
                w.x = cvt_pk_bf16(silu_f(g0[0]) * u0[0], silu_f(g0[1]) * u0[1]); w.y = cvt_pk_bf16(silu_f(g0[2]) * u0[2], silu_f(g0[3]) * u0[3]);
                w.z = cvt_pk_bf16(silu_f(g1[0]) * u1[0], silu_f(g1[1]) * u1[1]); w.w = cvt_pk_bf16(silu_f(g1[2]) * u1[2], silu_f(g1[3]) * u1[3]);
                *(u32x4*)rowp = w; }
    }
};
struct EpiResid {
    static constexpr bool PERM = false, AFTER_DRAIN = false;
    const float* base0; const float* base1; int split; float* out; int ldc; float alpha;
    __device__ __forceinline__ void operator()(const f32x4 (&acc)[2][2][4][2], const Unit& u, int wr, int wc, int fr, int fq) const {
        const int row0 = u.pm * BM + wr * 64 + fr; const int col0 = u.pn * BM + wc * 32 + 4 * fq;
        const float* bs = (u.pm * BM < split) ? base0 : base1 - (size_t)split * ldc;
#pragma unroll
        for (int ai = 0; ai < 2; ++ai)
#pragma unroll
            for (int m = 0; m < 4; ++m) { const size_t off = (size_t)(row0 + ai * HALF + m * 16) * ldc + col0;
#pragma unroll
                for (int bj = 0; bj < 2; ++bj)
#pragma unroll
                    for (int n = 0; n < 2; ++n) { const f32x4 b = *(const f32x4*)(bs + off + bj * HALF + n * 16);
                        *(f32x4*)(out + off + bj * HALF + n * 16) = b + acc[ai][bj][m][n] * alpha; }
                if (m & 1) asm volatile("" ::: "memory"); }
    }
};
struct EpiFilt {
    static constexpr bool PERM = false, AFTER_DRAIN = false;
    float* Ts; float* Tp; const float* decay;
    __device__ __forceinline__ void operator()(const f32x4 (&acc)[2][2][4][2], const Unit& u, int wr, int wc, int fr, int fq) const {
        const int row0 = u.pm * BM + wr * 64 + fr; const int colt = u.pn * BM; const bool smp = colt < 8192;
        const int L = smp ? 8192 : 4096; float* T = smp ? Ts : Tp; const float rl1 = -1.4426950408889634f / (float)(L - 1);
        const int col0 = (smp ? colt : colt - 8192) + wc * 32 + 4 * fq;
#pragma unroll
        for (int ai = 0; ai < 2; ++ai)
#pragma unroll
            for (int m = 0; m < 4; ++m) { const int j = row0 + ai * HALF + m * 16; const float a = fabsf(decay[j]) * rl1; float* rowp = T + (size_t)j * L + col0;
#pragma unroll
                for (int bj = 0; bj < 2; ++bj)
#pragma unroll
                    for (int n = 0; n < 2; ++n) { const int t = col0 + bj * HALF + n * 16; f32x4 v = acc[ai][bj][m][n];
                        v[0] *= __builtin_amdgcn_exp2f((float)t * a); v[1] *= __builtin_amdgcn_exp2f((float)(t + 1) * a); v[2] *= __builtin_amdgcn_exp2f((float)(t + 2) * a); v[3] *= __builtin_amdgcn_exp2f((float)(t + 3) * a);
                        *(f32x4*)(rowp + bj * HALF + n * 16) = v; } }
    }
};
struct EpiQKV {
    static constexpr bool PERM = true, AFTER_DRAIN = false;
    bf16_t* O; int ldc; const float* qn; const float* kn; PG8_LAS unsigned char* xl;
    __device__ __forceinline__ void operator()(f32x4 (&acc)[2][2][4][2], const Unit& u, int wr, int wc, int fr, int fq) const {
        const int row0 = u.pm * BM + wr * 64 + fr; const int col0 = u.pn * BM + wc * 32 + 8 * fq;
        if (u.pn < 5) {
            PG8_LAS float* P = (PG8_LAS float*)xl; PG8_LAS float* S = P + 2048;
            int tid = threadIdx.x; asm volatile("" : "+v"(tid), "+v"(fr));
#pragma unroll
            for (int ai = 0; ai < 2; ++ai)
#pragma unroll
                for (int m = 0; m < 4; ++m)
#pragma unroll
                    for (int bj = 0; bj < 2; ++bj) { const f32x4 a = acc[ai][bj][m][0], b = acc[ai][bj][m][1];
                        float s = ((a[0] * a[0] + a[1] * a[1]) + (a[2] * a[2] + a[3] * a[3])) + ((b[0] * b[0] + b[1] * b[1]) + (b[2] * b[2] + b[3] * b[3]));
                        s += __shfl_xor(s, 16); s += __shfl_xor(s, 32);
                        if (fq == 0) P[((ai * HALF + wr * 64 + m * 16 + fr) * 2 + bj) * 4 + wc] = s; }
            asm volatile("s_waitcnt lgkmcnt(0)" ::: "memory"); __builtin_amdgcn_s_barrier(); asm volatile("" ::: "memory");
            { const f32x4 p = *(const PG8_LAS f32x4*)(P + 4 * tid); S[tid] = 1.0f / sqrtf(((p[0] + p[1]) + (p[2] + p[3])) * (1.0f / 128.0f) + 1e-6f); }
            asm volatile("s_waitcnt lgkmcnt(0)" ::: "memory"); __builtin_amdgcn_s_barrier(); asm volatile("" ::: "memory");
            const float* gn = (u.pn < 4) ? qn : kn; const float qs = (u.pn < 4) ? 0.12751743082459868f : 1.0f;
            asm volatile("" : "+v"(fq));
            const int h64 = (wc >> 1) * 64;
            float inv[4], g1[4], g2[4];
#pragma unroll
            for (int pr = 0; pr < 4; ++pr) { const int i = 16 * (wc & 1) + 4 * fq + pr;
                inv[pr] = __builtin_amdgcn_exp2f(-(float)i * (13.287712379549449f / 32.0f)) * 0.15915494309189535f; g1[pr] = gn[h64 + i] * qs; g2[pr] = gn[h64 + 32 + i] * qs; }
#pragma unroll
            for (int ai = 0; ai < 2; ++ai)
#pragma unroll
                for (int m = 0; m < 4; ++m) { const int rl = ai * HALF + wr * 64 + m * 16 + fr, row = u.pm * BM + rl;
                    const int t = row < 8192 ? (row & 4095) : ((row - 8192) & 8191); const float pos = h64 ? (float)(t & 63) : (float)(t >> 6);
                    float c[4], sn[4];
#pragma unroll
                    for (int pr = 0; pr < 4; ++pr) { const float turns = pos * inv[pr]; c[pr] = __builtin_amdgcn_cosf(turns); sn[pr] = __builtin_amdgcn_sinf(turns); }
                    bf16_t* rowp = O + (size_t)row * ldc + col0;
#pragma unroll
                    for (int bj = 0; bj < 2; ++bj) { const float rs = S[rl * 2 + bj]; const f32x4 a = acc[ai][bj][m][0], b = acc[ai][bj][m][1];
                        const float x0 = a[0] * rs * g1[0], y0 = a[1] * rs * g2[0], x1 = a[2] * rs * g1[1], y1 = a[3] * rs * g2[1];
                        const float x2 = b[0] * rs * g1[2], y2 = b[1] * rs * g2[2], x3 = b[2] * rs * g1[3], y3 = b[3] * rs * g2[3];
                        u32x4 w; w.x = cvt_pk_bf16(x0 * c[0] - y0 * sn[0], y0 * c[0] + x0 * sn[0]); w.y = cvt_pk_bf16(x1 * c[1] - y1 * sn[1], y1 * c[1] + x1 * sn[1]);
                        w.z = cvt_pk_bf16(x2 * c[2] - y2 * sn[2], y2 * c[2] + x2 * sn[2]); w.w = cvt_pk_bf16(x3 * c[3] - y3 * sn[3], y3 * c[3] + x3 * sn[3]);
                        *(u32x4*)(rowp + bj * HALF) = w; } }
            asm volatile("s_waitcnt lgkmcnt(0)" ::: "memory"); __builtin_amdgcn_s_barrier(); asm volatile("" ::: "memory");
        } else {
#pragma unroll
            for (int ai = 0; ai < 2; ++ai)
#pragma unroll
                for (int m = 0; m < 4; ++m) { bf16_t* rowp = O + (size_t)(row0 + ai * HALF + m * 16) * ldc + col0;
#pragma unroll
                    for (int bj = 0; bj < 2; ++bj) { const f32x4 v0 = acc[ai][bj][m][0], v1 = acc[ai][bj][m][1];
                        u32x4 w; w.x = cvt_pk_bf16(v0[0], v0[1]); w.y = cvt_pk_bf16(v0[2], v0[3]); w.z = cvt_pk_bf16(v1[0], v1[1]); w.w = cvt_pk_bf16(v1[2], v1[3]);
                        *(u32x4*)(rowp + bj * HALF) = w; } }
            asm volatile("s_waitcnt lgkmcnt(0)" ::: "memory"); __builtin_amdgcn_s_barrier(); __builtin_amdgcn_s_barrier(); __builtin_amdgcn_s_barrier();
        }
    }
};
struct PanelOrder {
    int c;
    __device__ __forceinline__ bool next(int i, Unit& u) const { if (i >= 5) return false; const int x = c & 7, k = c >> 3; u.pm = 32 * i + 4 * x + (k >> 3); u.pn = k & 7; return true; }
    __device__ __forceinline__ void a_ready(const Unit&) const {}
    __device__ __forceinline__ void done(const Unit&) const {}
};
struct EpiRmsFinal {
    static constexpr bool PERM = false, AFTER_DRAIN = false;
    const float* base; float* out; int ldc; float alpha; const float* g; float* part; unsigned* cnt; PG8_LAS unsigned char* xl;
    __device__ __forceinline__ void operator()(f32x4 (&acc)[2][2][4][2], const Unit& u, int wr, int wc, int fr, int fq) const {
        PG8_LAS float* P = (PG8_LAS float*)xl; PG8_LAS float* S = P + 1024; PG8_LAS unsigned* flag = (PG8_LAS unsigned*)(S + 256);
        const int tid = threadIdx.x, lane = tid & 63, wid = tid >> 6;
        const int row0 = u.pm * BM + wr * 64 + fr; const int col0 = u.pn * BM + wc * 32 + 4 * fq;
#pragma unroll
        for (int ai = 0; ai < 2; ++ai)
#pragma unroll
            for (int m = 0; m < 4; ++m) { const size_t off = (size_t)(row0 + ai * HALF + m * 16) * ldc + col0; float s = 0.f;
#pragma unroll
                for (int bj = 0; bj < 2; ++bj)
#pragma unroll
                    for (int n = 0; n < 2; ++n) { const f32x4 b = *(const f32x4*)(base + off + bj * HALF + n * 16); const f32x4 v = b + acc[ai][bj][m][n] * alpha; acc[ai][bj][m][n] = v;
                        s += (v[0] * v[0] + v[1] * v[1]) + (v[2] * v[2] + v[3] * v[3]); }
                s += __shfl_xor(s, 16); s += __shfl_xor(s, 32);
                if (fq == 0) P[(ai * HALF + wr * 64 + m * 16 + fr) * 4 + wc] = s;
                if (m & 1) asm volatile("" ::: "memory"); }
        asm volatile("s_waitcnt lgkmcnt(0)" ::: "memory"); __builtin_amdgcn_s_barrier(); asm volatile("" ::: "memory");
        const int row = wid * 32 + (lane & 31);
        float* prow = part + ((size_t)(u.pm * BM + row)) * 8;
        if (lane < 32) { const float tot = (P[row * 4] + P[row * 4 + 1]) + (P[row * 4 + 2] + P[row * 4 + 3]); __hip_atomic_store(prow + u.pn, tot, __ATOMIC_RELAXED, __HIP_MEMORY_SCOPE_AGENT); }
        asm volatile("s_waitcnt vmcnt(0)" ::: "memory");
        if (lane == 0) __hip_atomic_fetch_add(cnt + 64 * u.pm, 1u, __ATOMIC_RELAXED, __HIP_MEMORY_SCOPE_AGENT);
        if (wid == 0) { unsigned polls = 0;
            while ((unsigned)__builtin_amdgcn_readfirstlane(__hip_atomic_load(cnt + 64 * u.pm, __ATOMIC_RELAXED, __HIP_MEMORY_SCOPE_AGENT)) < 64u) { __builtin_amdgcn_s_sleep(2); if (++polls > (1u << 22)) break; }
            (void)flag; }
        asm volatile("s_waitcnt vmcnt(0) lgkmcnt(0)" ::: "memory"); __builtin_amdgcn_s_barrier(); asm volatile("" ::: "memory");
        if (lane < 32) { float t = 0.f;
#pragma unroll
            for (int j = 0; j < 8; ++j) t += __hip_atomic_load(prow + j, __ATOMIC_RELAXED, __HIP_MEMORY_SCOPE_AGENT);
            S[row] = 1.0f / sqrtf(t * (1.0f / 2048.0f) + 1e-6f); }
        asm volatile("s_waitcnt lgkmcnt(0)" ::: "memory"); __builtin_amdgcn_s_barrier(); asm volatile("" ::: "memory");
#pragma unroll
        for (int ai = 0; ai < 2; ++ai)
#pragma unroll
            for (int m = 0; m < 4; ++m) { const int r = ai * HALF + wr * 64 + m * 16 + fr; const float rs = S[r]; const size_t off = (size_t)(u.pm * BM + r) * ldc + col0;
#pragma unroll
                for (int bj = 0; bj < 2; ++bj)
#pragma unroll
                    for (int n = 0; n < 2; ++n) { const f32x4 gg = *(const f32x4*)(g + col0 + bj * HALF + n * 16); *(f32x4*)(out + off + bj * HALF + n * 16) = acc[ai][bj][m][n] * rs * gg; } }
        asm volatile("s_waitcnt lgkmcnt(0)" ::: "memory"); __builtin_amdgcn_s_barrier(); asm volatile("" ::: "memory");
    }
};
struct EpiRmsX {
    static constexpr bool PERM = false, AFTER_DRAIN = false;
    const float* base0; const float* base1; int split; float* out; bf16_t* xn; int ldc; float alpha; const float* g; float* part; unsigned* cnt; PG8_LAS unsigned char* xl;
    __device__ __forceinline__ void operator()(f32x4 (&acc)[2][2][4][2], const Unit& u, int wr, int wc, int fr, int fq) const {
        PG8_LAS float* P = (PG8_LAS float*)xl; PG8_LAS float* S = P + 1024; PG8_LAS unsigned* flag = (PG8_LAS unsigned*)(S + 256);
        const int tid = threadIdx.x, lane = tid & 63, wid = tid >> 6;
        const int row0 = u.pm * BM + wr * 64 + fr; const int col0 = u.pn * BM + wc * 32 + 4 * fq;
        const float* base = (u.pm * BM < split) ? base0 : base1 - (size_t)split * ldc;
#pragma unroll
        for (int ai = 0; ai < 2; ++ai)
#pragma unroll
            for (int m = 0; m < 4; ++m) { const size_t off = (size_t)(row0 + ai * HALF + m * 16) * ldc + col0; float s = 0.f;
#pragma unroll
                for (int bj = 0; bj < 2; ++bj)
#pragma unroll
                    for (int n = 0; n < 2; ++n) { const f32x4 b = *(const f32x4*)(base + off + bj * HALF + n * 16); const f32x4 v = b + acc[ai][bj][m][n] * alpha; acc[ai][bj][m][n] = v; *(f32x4*)(out + off + bj * HALF + n * 16) = v;
                        s += (v[0] * v[0] + v[1] * v[1]) + (v[2] * v[2] + v[3] * v[3]); }
                s += __shfl_xor(s, 16); s += __shfl_xor(s, 32);
                if (fq == 0) P[(ai * HALF + wr * 64 + m * 16 + fr) * 4 + wc] = s;
                if (m & 1) asm volatile("" ::: "memory"); }
        asm volatile("s_waitcnt lgkmcnt(0)" ::: "memory"); __builtin_amdgcn_s_barrier(); asm volatile("" ::: "memory");
        const int row = wid * 32 + (lane & 31);
        float* prow = part + ((size_t)(u.pm * BM + row)) * 8;
        if (lane < 32) { const float tot = (P[row * 4] + P[row * 4 + 1]) + (P[row * 4 + 2] + P[row * 4 + 3]); __hip_atomic_store(prow + u.pn, tot, __ATOMIC_RELAXED, __HIP_MEMORY_SCOPE_AGENT); }
        asm volatile("s_waitcnt vmcnt(0)" ::: "memory");
        if (lane == 0) __hip_atomic_fetch_add(cnt + 64 * u.pm, 1u, __ATOMIC_RELAXED, __HIP_MEMORY_SCOPE_AGENT);
        if (wid == 0) { unsigned polls = 0;
            while ((unsigned)__builtin_amdgcn_readfirstlane(__hip_atomic_load(cnt + 64 * u.pm, __ATOMIC_RELAXED, __HIP_MEMORY_SCOPE_AGENT)) < 64u) { __builtin_amdgcn_s_sleep(2); if (++polls > (1u << 22)) break; }
            (void)flag; }
        asm volatile("s_waitcnt vmcnt(0) lgkmcnt(0)" ::: "memory"); __builtin_amdgcn_s_barrier(); asm volatile("" ::: "memory");
        if (lane < 32) { float t = 0.f;
#pragma unroll
            for (int j = 0; j < 8; ++j) t += __hip_atomic_load(prow + j, __ATOMIC_RELAXED, __HIP_MEMORY_SCOPE_AGENT);
            S[row] = 1.0f / sqrtf(t * (1.0f / 2048.0f) + 1e-6f); }
        asm volatile("s_waitcnt lgkmcnt(0)" ::: "memory"); __builtin_amdgcn_s_barrier(); asm volatile("" ::: "memory");
#pragma unroll
        for (int ai = 0; ai < 2; ++ai)
#pragma unroll
            for (int m = 0; m < 4; ++m) { const int r = ai * HALF + wr * 64 + m * 16 + fr; const float rs = S[r]; const size_t off = (size_t)(u.pm * BM + r) * ldc + col0;
#pragma unroll
                for (int bj = 0; bj < 2; ++bj)
#pragma unroll
                    for (int n = 0; n < 2; ++n) { const f32x4 gg = *(const f32x4*)(g + col0 + bj * HALF + n * 16); const f32x4 y = acc[ai][bj][m][n] * rs * gg; typedef unsigned u32x2_t __attribute__((ext_vector_type(2))); u32x2_t w; w.x = cvt_pk_bf16(y[0], y[1]); w.y = cvt_pk_bf16(y[2], y[3]); *(u32x2_t*)(xn + off + bj * HALF + n * 16) = w; } }
        asm volatile("s_waitcnt lgkmcnt(0)" ::: "memory"); __builtin_amdgcn_s_barrier(); asm volatile("" ::: "memory");
    }
};
template <class Epi, class Sched, bool ALIGN_EPI = false, bool SP2 = false>
__device__ __forceinline__ void gemm_phase(PG8_LAS unsigned char* lds, const Gemm g, const Sched& S, const Epi& E) {
    const int tid = threadIdx.x, wid = __builtin_amdgcn_readfirstlane(tid >> 6), lane = tid & 63, wr = wid >> 2, wc = wid & 3, fr = lane & 15, fq = lane >> 4;
    const int K = g.K, nt = K / BK;
    unsigned voffA[2], voffB[2];
#pragma unroll
    for (int i = 0; i < 2; ++i) { int R, C; stage_rc(tid * 16 + i * 8192, R, C); const int Rb = Epi::PERM ? ((R & ~31) + perm32(R & 31)) : R;
        voffA[i] = (unsigned)(R * K + C) * 2u; voffB[i] = (unsigned)(Rb * K + C) * 2u; }
    const size_t kstep = (size_t)(BK * 2);
    const size_t hstep = (size_t)HALF * K * 2;
    const size_t tstep = 2 * hstep;
    const unsigned ldsw = (unsigned)wid * 1024u;
    const int aoff = lds_byte(wr * 64 + fr, fq * 8), boff = lds_byte(wc * 32 + fr, fq * 8);
#define PG8_SA(b, h) (((b) * 2 + (h)) * HTB)
#define PG8_SB(b, h) ((4 + (b) * 2 + (h)) * HTB)
#define PG8_STAGE(bufoff, gbase, voff) do { _Pragma("unroll") for (int _i = 0; _i < 2; ++_i) \
        __builtin_amdgcn_global_load_lds((const unsigned*)((const char*)(gbase) + (voff)[_i]), (PG8_LAS unsigned*)(lds + (bufoff) + ldsw + _i * 8192), 16, 0, 0); } while (0)
#define PG8_LDA(dst, b, h) do { _Pragma("unroll") for (int m = 0; m < 4; ++m) _Pragma("unroll") for (int k = 0; k < 2; ++k) dst[m][k] = *(const PG8_LAS bf16x8*)(lds + PG8_SA(b, h) + aoff + m * 2048 + k * 1024); } while (0)
#define PG8_LDB(dst, b, h) do { _Pragma("unroll") for (int n = 0; n < 2; ++n) _Pragma("unroll") for (int k = 0; k < 2; ++k) dst[n][k] = *(const PG8_LAS bf16x8*)(lds + PG8_SB(b, h) + boff + n * 2048 + k * 1024); } while (0)
#define PG8_MMA(ai, bj, At, Bt) do { __builtin_amdgcn_s_setprio(1); _Pragma("unroll") for (int m = 0; m < 4; ++m) _Pragma("unroll") for (int n = 0; n < 2; ++n) _Pragma("unroll") for (int k = 0; k < 2; ++k) \
        acc[ai][bj][m][n] = __builtin_amdgcn_mfma_f32_16x16x32_bf16(Bt[n][k], At[m][k], acc[ai][bj][m][n], 0, 0, 0); __builtin_amdgcn_s_setprio(0); } while (0)
#define PG8_WAIT_V(n) asm volatile("s_waitcnt vmcnt(" #n ")" ::: "memory")
#define PG8_WAIT_L(n) asm volatile("s_waitcnt lgkmcnt(" #n ")" ::: "memory")
#define PG8_BAR __builtin_amdgcn_s_barrier()
#define PG8_SCHED __builtin_amdgcn_sched_barrier(0)
    Unit cur, nxt; int ui = 0;
    if (!S.next(0, cur)) return;
    f32x4 acc[2][2][4][2];
#pragma unroll
    for (int a = 0; a < 2; ++a)
#pragma unroll
        for (int b = 0; b < 2; ++b)
#pragma unroll
            for (int m = 0; m < 4; ++m)
#pragma unroll
                for (int n = 0; n < 2; ++n) acc[a][b][m][n] = (f32x4){0.f, 0.f, 0.f, 0.f};
    bf16x8 At[4][2], B0[2][2], B1[2][2];
    const char* cA = (const char*)g.A + (size_t)cur.pm * tstep; const char* cB = (const char*)g.Bt + (size_t)cur.pn * tstep;
    S.a_ready(cur);
    if constexpr (SP2) {
        PG8_STAGE(PG8_SB(0, 0), cB, voffB); PG8_STAGE(PG8_SB(0, 1), cB + hstep, voffB); PG8_STAGE(PG8_SA(0, 0), cA, voffA); PG8_STAGE(PG8_SA(0, 1), cA + hstep, voffA);
        if (wr == 1) PG8_BAR;
        PG8_WAIT_V(2); PG8_BAR;
        PG8_STAGE(PG8_SB(1, 0), cB + kstep, voffB); PG8_STAGE(PG8_SA(1, 0), cA + kstep, voffA); PG8_STAGE(PG8_SB(1, 1), cB + hstep + kstep, voffB);
        PG8_WAIT_V(6); PG8_BAR;
    } else {
        PG8_STAGE(PG8_SB(0, 0), cB, voffB); PG8_STAGE(PG8_SA(0, 0), cA, voffA); PG8_STAGE(PG8_SB(0, 1), cB + hstep, voffB); PG8_STAGE(PG8_SA(0, 1), cA + hstep, voffA);
        if (wr == 1) PG8_BAR;
        PG8_WAIT_V(4); PG8_BAR;
        PG8_STAGE(PG8_SB(1, 0), cB + kstep, voffB); PG8_STAGE(PG8_SA(1, 0), cA + kstep, voffA); PG8_STAGE(PG8_SB(1, 1), cB + hstep + kstep, voffB);
        PG8_WAIT_V(6); PG8_BAR;
    }
    for (;;) {
        const bool has_next = S.next(ui + 1, nxt);
        const char* nA = has_next ? (const char*)g.A + (size_t)nxt.pm * tstep : cA; const char* nB = has_next ? (const char*)g.Bt + (size_t)nxt.pn * tstep : cB;
        for (int t = 0; t < nt; t += 2) {
            const bool last = (t == nt - 2);
            const char* a1 = cA + (size_t)(t + 1) * kstep;
            const char* a2 = last ? nA : cA + (size_t)(t + 2) * kstep; const char* b2 = last ? nB : cB + (size_t)(t + 2) * kstep;
            const char* a3 = a2 + kstep; const char* b3 = b2 + kstep;
            if (last && has_next) S.a_ready(nxt);
            if constexpr (SP2) {
            PG8_LDB(B0, 0, 0); PG8_LDB(B1, 0, 1); PG8_SCHED; PG8_LDA(At, 0, 0); PG8_STAGE(PG8_SA(1, 1), a1 + hstep, voffA);
            PG8_WAIT_V(8); PG8_WAIT_L(0); PG8_BAR; PG8_MMA(0, 0, At, B0); PG8_MMA(0, 1, At, B1); PG8_BAR; PG8_SCHED;
            PG8_LDA(At, 0, 1); PG8_STAGE(PG8_SB(0, 0), b2, voffB); PG8_STAGE(PG8_SB(0, 1), b2 + hstep, voffB); PG8_STAGE(PG8_SA(0, 0), a2, voffA);
            PG8_WAIT_V(8); PG8_WAIT_L(0); PG8_BAR; PG8_MMA(1, 0, At, B0); PG8_MMA(1, 1, At, B1); PG8_BAR; PG8_SCHED;
            PG8_LDB(B0, 1, 0); PG8_LDB(B1, 1, 1); PG8_SCHED; PG8_LDA(At, 1, 0); PG8_STAGE(PG8_SA(0, 1), a2 + hstep, voffA);
            PG8_WAIT_V(8); PG8_WAIT_L(0); PG8_BAR; PG8_MMA(0, 0, At, B0); PG8_MMA(0, 1, At, B1); PG8_BAR; PG8_SCHED;
            PG8_LDA(At, 1, 1); PG8_STAGE(PG8_SB(1, 0), b3, voffB); PG8_STAGE(PG8_SB(1, 1), b3 + hstep, voffB); PG8_STAGE(PG8_SA(1, 0), a3, voffA);
            PG8_WAIT_V(8); PG8_WAIT_L(0); PG8_BAR; PG8_MMA(1, 0, At, B0); PG8_MMA(1, 1, At, B1); PG8_BAR; PG8_SCHED;
            } else {
            PG8_LDB(B0, 0, 0); PG8_SCHED; PG8_LDA(At, 0, 0); PG8_STAGE(PG8_SA(1, 1), a1 + hstep, voffA);
            PG8_WAIT_L(8); PG8_BAR; PG8_WAIT_L(0); PG8_MMA(0, 0, At, B0); PG8_BAR; PG8_SCHED;
            PG8_LDB(B1, 0, 1); PG8_STAGE(PG8_SB(0, 0), b2, voffB);
            PG8_BAR; PG8_WAIT_L(0); PG8_MMA(0, 1, At, B1); PG8_BAR;
            PG8_LDA(At, 0, 1); PG8_STAGE(PG8_SA(0, 0), a2, voffA);
            PG8_BAR; PG8_WAIT_L(0); PG8_MMA(1, 0, At, B0); PG8_BAR; PG8_SCHED;
            PG8_STAGE(PG8_SB(0, 1), b2 + hstep, voffB);
            PG8_WAIT_V(6); PG8_BAR; PG8_MMA(1, 1, At, B1); PG8_BAR;
            PG8_LDB(B0, 1, 0); PG8_SCHED; PG8_LDA(At, 1, 0); PG8_STAGE(PG8_SA(0, 1), a2 + hstep, voffA);
            PG8_WAIT_L(8); PG8_BAR; PG8_WAIT_L(0); PG8_MMA(0, 0, At, B0); PG8_BAR; PG8_SCHED;
            PG8_LDB(B1, 1, 1); PG8_STAGE(PG8_SB(1, 0), b3, voffB);
            PG8_BAR; PG8_WAIT_L(0); PG8_MMA(0, 1, At, B1); PG8_BAR;
            PG8_LDA(At, 1, 1); PG8_STAGE(PG8_SA(1, 0), a3, voffA);
            PG8_BAR; PG8_WAIT_L(0); PG8_MMA(1, 0, At, B0); PG8_BAR; PG8_SCHED;
            PG8_STAGE(PG8_SB(1, 1), b3 + hstep, voffB);
            PG8_WAIT_V(6); PG8_BAR; PG8_MMA(1, 1, At, B1); PG8_BAR;
            }
        }
        if constexpr (ALIGN_EPI) { if (wr == 0) PG8_BAR; }
        if constexpr (!Epi::AFTER_DRAIN) { E(acc, cur, wr, wc, fr, fq); S.done(cur); }
        if (!has_next) break;
#pragma unroll
        for (int a = 0; a < 2; ++a)
#pragma unroll
            for (int b = 0; b < 2; ++b)
#pragma unroll
                for (int m = 0; m < 4; ++m)
#pragma unroll
                    for (int n = 0; n < 2; ++n) acc[a][b][m][n] = (f32x4){0.f, 0.f, 0.f, 0.f};
        cur = nxt; cA = nA; cB = nB; ++ui;
        if constexpr (ALIGN_EPI) { if (wr == 1) PG8_BAR; }
    }
    PG8_WAIT_V(0);
    if constexpr (!ALIGN_EPI) { if (wr == 0) PG8_BAR; }
    PG8_BAR;
    if constexpr (Epi::AFTER_DRAIN) { E.fused(acc, cur, wr, wc, fr, fq, lds, wid, lane); S.done(cur); }
#undef PG8_SA
#undef PG8_SB
#undef PG8_STAGE
#undef PG8_LDA
#undef PG8_LDB
#undef PG8_MMA
#undef PG8_WAIT_V
#undef PG8_WAIT_L
#undef PG8_BAR
#undef PG8_SCHED
}
}
namespace attn {
typedef unsigned short bf16;
constexpr int   D = 128, NW = 8, QBLK = 32, KVBLK = 64;
constexpr float SCALE = 0.088388347648318440f;
constexpr float THR = 8.f;
constexpr int LDQ = 1536, LDK = 1536, LDO = 2048;
constexpr size_t SHM_V = KVBLK * D * 2, SHM_K = KVBLK * D * 2, SHM_ATTN = 2 * SHM_V + 2 * SHM_K + NW * 64 * 4;
using bf16x8 = __attribute__((ext_vector_type(8))) short;
using s16x4  = __attribute__((ext_vector_type(4))) short;
using f32x16 = __attribute__((ext_vector_type(16))) float;
using u32x4  = __attribute__((ext_vector_type(4))) unsigned;
#define KSWZ(row, colB) ((row) * 256 + ((colB) ^ (((row) & 7) << 4)))
#define SBAR() __builtin_amdgcn_sched_barrier(0)
__device__ __forceinline__ int crow(int r, int hi) { return (r & 3) + 8 * (r >> 2) + 4 * hi; }
__device__ __forceinline__ unsigned cvtpk(float lo, float hi) {
  unsigned r; asm volatile("v_cvt_pk_bf16_f32 %0, %1, %2" : "=v"(r) : "v"(lo), "v"(hi)); return r;
}
__device__ __forceinline__ bf16x8 ld8(const bf16* p) { return *reinterpret_cast<const bf16x8*>(p); }
__device__ __forceinline__ void expA(f32x16& p0, const float negb) { p0 = p0 + negb; for (int r = 0; r < 16; ++r) p0[r] = __builtin_amdgcn_exp2f(p0[r]); }
__device__ __forceinline__ void finishSM(f32x16& p0, f32x16& p1, const float negb, float& l_reg, bf16x8& pa0, bf16x8& pa1, bf16x8& pa2, bf16x8& pa3) {
  p1 = p1 + negb; for (int r = 0; r < 16; ++r) p1[r] = __builtin_amdgcn_exp2f(p1[r]);
  float ps = 0; for (int r = 0; r < 16; ++r) ps += p0[r]; for (int r = 0; r < 16; ++r) ps += p1[r];
  l_reg += ps;
#define PK4(P, BASE, OUT) do { unsigned a0 = cvtpk(P[BASE + 0], P[BASE + 1]), a1 = cvtpk(P[BASE + 2], P[BASE + 3]);   \
    unsigned b0 = cvtpk(P[BASE + 4], P[BASE + 5]), b1 = cvtpk(P[BASE + 6], P[BASE + 7]);                              \
    auto r0 = __builtin_amdgcn_permlane32_swap(a0, b0, false, false); auto r1 = __builtin_amdgcn_permlane32_swap(a1, b1, false, false); \
    u32x4 w = {r0[0], r1[0], r0[1], r1[1]}; OUT = *reinterpret_cast<bf16x8*>(&w); } while (0)
  PK4(p0, 0, pa0); PK4(p0, 8, pa1); PK4(p1, 0, pa2); PK4(p1, 8, pa3);
#undef PK4
}
__device__ __forceinline__ void qkt(f32x16& p0, f32x16& p1, const bf16* Ks, const bf16x8* qr, int r32, int hi) {
  p0 = f32x16{}; p1 = f32x16{};
  for (int d0 = 0; d0 < 8; ++d0) { int cb = (d0 * 16 + hi * 8) * 2;
    bf16x8 b0 = *reinterpret_cast<const bf16x8*>((const char*)Ks + KSWZ(r32, cb));
    bf16x8 b1 = *reinterpret_cast<const bf16x8*>((const char*)Ks + KSWZ(32 + r32, cb));
    p0 = __builtin_amdgcn_mfma_f32_32x32x16_bf16(b0, qr[d0], p0, 0, 0, 0);
    p1 = __builtin_amdgcn_mfma_f32_32x32x16_bf16(b1, qr[d0], p1, 0, 0, 0); }
}
__device__ __forceinline__ int v_st(int k, int c) { const int kk = (k & ~0xC) | ((k & 4) << 1) | ((k & 8) >> 1); return ((kk >> 3) * 4 + (c >> 5)) * 512 + ((kk & 7) * 32 + (c & 31)) * 2; }
__device__ __forceinline__ int v_rd_base(int lane) { return ((lane & 3) << 3) | (((lane >> 2) & 3) << 6) | (((lane >> 4) & 1) << 5) | (((lane >> 5) & 1) << 8); }
constexpr int v_rd_off(int d0, int ks, int half) { return d0 * 512 + ks * 4096 + half * 2048; }
template <int OFF> __device__ __forceinline__ s16x4 tr_read(int vb) {
  s16x4 r; asm volatile("ds_read_b64_tr_b16 %0, %1 offset:%2" : "=&v"(r) : "v"(vb), "i"(OFF) : "memory"); return r;
}
template <int D0> __device__ __forceinline__ void pv_one(f32x16& od, int vb, bf16x8 pa0, bf16x8 pa1, bf16x8 pa2, bf16x8 pa3) {
  const s16x4 l0 = tr_read<v_rd_off(D0, 0, 0)>(vb), h0 = tr_read<v_rd_off(D0, 0, 1)>(vb), l1 = tr_read<v_rd_off(D0, 1, 0)>(vb), h1 = tr_read<v_rd_off(D0, 1, 1)>(vb);
  const s16x4 l2 = tr_read<v_rd_off(D0, 2, 0)>(vb), h2 = tr_read<v_rd_off(D0, 2, 1)>(vb), l3 = tr_read<v_rd_off(D0, 3, 0)>(vb), h3 = tr_read<v_rd_off(D0, 3, 1)>(vb);
  asm volatile("s_waitcnt lgkmcnt(0)" ::: "memory"); SBAR();
#define PK(L, H) (bf16x8){L[0], L[1], L[2], L[3], H[0], H[1], H[2], H[3]}
  od = __builtin_amdgcn_mfma_f32_32x32x16_bf16(pa0, PK(l0, h0), od, 0, 0, 0);
  od = __builtin_amdgcn_mfma_f32_32x32x16_bf16(pa1, PK(l1, h1), od, 0, 0, 0);
  od = __builtin_amdgcn_mfma_f32_32x32x16_bf16(pa2, PK(l2, h2), od, 0, 0, 0);
  od = __builtin_amdgcn_mfma_f32_32x32x16_bf16(pa3, PK(l3, h3), od, 0, 0, 0);
#undef PK
}
__device__ __forceinline__ void pv_d0(f32x16* o, int vb, bf16x8 pa0, bf16x8 pa1, bf16x8 pa2, bf16x8 pa3) {
  pv_one<0>(o[0], vb, pa0, pa1, pa2, pa3); pv_one<1>(o[1], vb, pa0, pa1, pa2, pa3); pv_one<2>(o[2], vb, pa0, pa1, pa2, pa3); pv_one<3>(o[3], vb, pa0, pa1, pa2, pa3);
}
__device__ __forceinline__ void attn_dense_body(const bf16* __restrict__ Qb, const bf16* __restrict__ Kh, const bf16* __restrict__ Vh,
                                                bf16* __restrict__ Ob, int seq, char* lds, const float negb) {
  const int tid = threadIdx.x, wid = tid >> 6, lane = tid & 63, r32 = lane & 31, hi = lane >> 5;
  bf16* V_lds = (bf16*)lds; bf16* K_lds = (bf16*)(lds + 2 * SHM_V);
  float* ws = (float*)(lds + 2 * SHM_V + 2 * SHM_K) + wid * 64; float* li_l = ws;
  float l_reg = 0; f32x16 o[4] = {}; bf16x8 qr[8];
  const bf16* Qw = Qb + (long)(wid * QBLK + r32) * LDQ + hi * 8;
#pragma unroll
  for (int d0 = 0; d0 < 8; ++d0) qr[d0] = ld8(Qw + d0 * 16);
  const int sr = tid >> 4, sc = (tid & 15) * 8, vst0 = v_st(sr, sc), vst1 = v_st(32 + sr, sc);
  const int vb0 = (int)(uintptr_t)V_lds + v_rd_base(lane);
  struct { bf16x8 vs0, vs1, ks0, ks1; } sr_[1];
  const unsigned so0 = (unsigned)(sr * LDK + sc);
#define SLOAD(i, k0) do { const unsigned a_ = (unsigned)(k0) * (unsigned)LDK + so0; sr_[i].vs0 = ld8(Kh + (a_ + 256u)); sr_[i].vs1 = ld8(Kh + (a_ + 32u * LDK + 256u)); \
    sr_[i].ks0 = ld8(Kh + a_); sr_[i].ks1 = ld8(Kh + (a_ + 32u * LDK)); } while (0)
#define SWRITE(b, i) do { *(bf16x8*)((char*)V_lds + (b) * SHM_V + vst0) = sr_[i].vs0;          \
    *(bf16x8*)((char*)V_lds + (b) * SHM_V + vst1) = sr_[i].vs1; int kc = sc * 2;               \
    *(bf16x8*)((char*)K_lds + (b) * SHM_K + KSWZ(sr, kc)) = sr_[i].ks0;                       \
    *(bf16x8*)((char*)K_lds + (b) * SHM_K + KSWZ(32 + sr, kc)) = sr_[i].ks1; } while (0)
#define SWAIT() asm volatile("s_waitcnt vmcnt(0)" ::: "memory")
  f32x16 pA0, pA1, pB0, pB1; bf16x8 pa0, pa1, pa2, pa3; const int NT = seq / KVBLK;
  constexpr int SE = 0, SO = 0;
  SLOAD(SE, 0); asm volatile("s_waitcnt vmcnt(0)" ::: "memory"); SWRITE(0, SE); __syncthreads();
  qkt(pA0, pA1, K_lds, qr, r32, hi); expA(pA0, negb);
  SLOAD(SO, KVBLK);
  SWAIT(); SWRITE(1, SO); __syncthreads();
  for (int j = 1; j + 1 < NT; j += 2) {
    SBAR(); qkt(pB0, pB1, (bf16*)((char*)K_lds + SHM_K), qr, r32, hi);
    finishSM(pA0, pA1, negb, l_reg, pa0, pa1, pa2, pa3); SBAR();
    SLOAD(SO, (j + 1) * KVBLK); SBAR();
    pv_d0(o, vb0, pa0, pa1, pa2, pa3); SBAR(); expA(pB0, negb); SBAR();
    __syncthreads(); SWAIT(); SWRITE(0, SE); SBAR();
    __syncthreads();
    SBAR(); qkt(pA0, pA1, K_lds, qr, r32, hi);
    finishSM(pB0, pB1, negb, l_reg, pa0, pa1, pa2, pa3); SBAR();
    SLOAD(SE, (j + 2) * KVBLK); SBAR();
    pv_d0(o, vb0 + (int)SHM_V, pa0, pa1, pa2, pa3); SBAR(); expA(pA0, negb); SBAR();
    __syncthreads(); SWAIT(); SWRITE(1, SO); SBAR();
    __syncthreads();
  }
  SBAR(); qkt(pB0, pB1, (bf16*)((char*)K_lds + SHM_K), qr, r32, hi);
  finishSM(pA0, pA1, negb, l_reg, pa0, pa1, pa2, pa3); SBAR();
  pv_d0(o, vb0, pa0, pa1, pa2, pa3); expA(pB0, negb);
  __syncthreads();
  finishSM(pB0, pB1, negb, l_reg, pa0, pa1, pa2, pa3); SBAR();
  pv_d0(o, vb0 + (int)SHM_V, pa0, pa1, pa2, pa3);
  { auto rr = __builtin_amdgcn_permlane32_swap(__float_as_uint(l_reg), __float_as_uint(l_reg), false, false); l_reg = __uint_as_float(rr[0]) + __uint_as_float(rr[1]); }
  if (hi == 0) li_l[r32] = l_reg; asm volatile("s_waitcnt lgkmcnt(0)" ::: "memory");
  float rli[16];
#pragma unroll
  for (int r = 0; r < 16; ++r) rli[r] = __builtin_amdgcn_rcpf(li_l[crow(r, hi)]);
  bf16* Ow = Ob + (long)(wid * QBLK) * LDO;
#pragma unroll
  for (int r = 0; r < 16; ++r) { int orow = crow(r, hi);
#pragma unroll
    for (int d0 = 0; d0 < 4; d0 += 2) { const unsigned pk = cvtpk(o[d0][r] * rli[r], o[d0 + 1][r] * rli[r]);
      Ow[(long)orow * LDO + d0 * 32 + r32] = (bf16)(pk & 0xffffu); Ow[(long)orow * LDO + (d0 + 1) * 32 + r32] = (bf16)(pk >> 16); } }
  __syncthreads();
#undef SLOAD
#undef SWRITE
#undef SWAIT
}
#undef KSWZ
#undef SBAR
}
#define LAS __attribute__((address_space(3)))
typedef unsigned short bf16_t;
typedef float f32x4 __attribute__((ext_vector_type(4)));
typedef unsigned u32x4v __attribute__((ext_vector_type(4)));
typedef unsigned u32x2v __attribute__((ext_vector_type(2)));
constexpr int NTHR = 512, NWAVES = 8;
constexpr int M_P = 8192, M_S = 32768, M_ALL = 40960, L_P = 4096, L_S = 8192;
constexpr int DM = 2048, DFF = 5632, NIN = 4608, NQKV = 1536, NHY = 3072, DH = 1024;
constexpr float EPS = 1e-6f;
constexpr size_t MiB = 1u << 20;
constexpr size_t WS_W13A = 2 * MiB, WS_W2A = 46 * MiB, WS_WIN = 68 * MiB, WS_WOUT = 86 * MiB, WS_W13B = 94 * MiB, WS_W2B = 138 * MiB;
constexpr size_t WS_XN = 160 * MiB, WS_ACT = 320 * MiB;
constexpr size_t WS_QKV = WS_ACT, WS_HYT = WS_ACT + 120 * MiB, WS_HYO = WS_ACT + 360 * MiB;
constexpr size_t WS_H2S = 760 * MiB, WS_H2P = 762 * MiB, WS_KSP = 764 * MiB, WS_FTS = 844 * MiB, WS_H2B = 972 * MiB, WS_W3T = 978 * MiB, WS_XN2 = 844 * MiB, WS_END = 1004 * MiB;
constexpr size_t WS_PCNT = 65536, WS_PART = 262144;
constexpr size_t WS_FTP = 2 * MiB;
constexpr int FFT_XBYTES = (16384 + 16384 / 16) * 8;
constexpr int LDS_COEF = FFT_XBYTES, LDS_RED = LDS_COEF + 1024, LDS_BYTES = 147456;
static_assert(LDS_RED + 256 <= LDS_BYTES, "lds map");

struct Args {
    const float* in[25]; float* out; unsigned char* ws; int ph_lo, ph_hi;
};

__device__ __forceinline__ float bf2f(bf16_t v) { return __uint_as_float((unsigned)v << 16); }
__device__ __forceinline__ unsigned f2bf(float f) { unsigned u = __float_as_uint(f); return (u + 0x7fffu + ((u >> 16) & 1u)) >> 16; }
__device__ __forceinline__ unsigned pk2(float lo, float hi) { return f2bf(lo) | (f2bf(hi) << 16); }
__device__ __forceinline__ float wave_sum(float v) {
#pragma unroll
    for (int o = 1; o < 64; o <<= 1) v += __shfl_xor(v, o);
    return v;
}
__device__ __forceinline__ float sin2pi(float turns) { return __builtin_amdgcn_sinf(turns); }
__device__ __forceinline__ float cos2pi(float turns) { return __builtin_amdgcn_cosf(turns); }
#define LDS_WAIT() asm volatile("s_waitcnt lgkmcnt(0)" ::: "memory")

__device__ __forceinline__ void transpose_item(const float* W, int K, int N, bf16_t* WT, int k0, int n0, int drow0, LAS float* scr, int lane, int dstride = 1) {
    float v[32]; const float* p = W + (size_t)(k0 + (lane >> 5)) * N + n0 + (lane & 31); const size_t rs2 = (size_t)2 * N;
#pragma unroll
    for (int i = 0; i < 32; ++i) v[i] = __builtin_nontemporal_load(p + i * rs2);
    LAS float* sp = scr + (lane >> 5) * 33 + (lane & 31);
#pragma unroll
    for (int i = 0; i < 32; ++i) sp[i * 66] = v[i];
    LDS_WAIT(); asm volatile("" ::: "memory");
    const int c = lane & 7;
#pragma unroll
    for (int j = 0; j < 4; ++j) { const int n = (lane >> 3) + 8 * j; const LAS float* s = scr + (8 * c) * 33 + n;
        u32x4v o; o.x = pk2(s[0 * 33], s[1 * 33]); o.y = pk2(s[2 * 33], s[3 * 33]); o.z = pk2(s[4 * 33], s[5 * 33]); o.w = pk2(s[6 * 33], s[7 * 33]);
        *(u32x4v*)(WT + (size_t)(drow0 + dstride * n) * K + k0 + 8 * c) = o; }
    LDS_WAIT(); asm volatile("" ::: "memory");
}
__device__ __forceinline__ int swiglu_row(int n0) { return n0 < DFF ? (n0 / 128) * 256 + (n0 % 128) : ((n0 - DFF) / 128) * 256 + 128 + ((n0 - DFF) % 128); }

__device__ __forceinline__ void rms_row_bf16(const float* xrow, const float* g, bf16_t* orow, int lane) {
    const f32x4* xr = (const f32x4*)xrow + lane; const f32x4* gr = (const f32x4*)g + lane;
    f32x4 v[8]; float s = 0.f;
#pragma unroll
    for (int j = 0; j < 8; ++j) { v[j] = __builtin_nontemporal_load(xr + 64 * j);        s += (v[j].x * v[j].x + v[j].y * v[j].y) + (v[j].z * v[j].z + v[j].w * v[j].w); }
    const float rstd = 1.0f / sqrtf(wave_sum(s) * (1.f / DM) + EPS);
    unsigned long long* o8 = (unsigned long long*)orow + lane;
#pragma unroll
    for (int j = 0; j < 8; ++j) { const f32x4 gg = gr[64 * j];
        o8[64 * j] = (unsigned long long)pk2(v[j].x * rstd * gg.x, v[j].y * rstd * gg.y) | ((unsigned long long)pk2(v[j].z * rstd * gg.z, v[j].w * rstd * gg.w) << 32); }
}
__device__ __forceinline__ void rms_row_f32(float* xrow, const float* g, int lane) {
    f32x4* xr = (f32x4*)xrow + lane; const f32x4* gr = (const f32x4*)g + lane;
    f32x4 v[8]; float s = 0.f;
#pragma unroll
    for (int j = 0; j < 8; ++j) { v[j] = xr[64 * j]; s += (v[j].x * v[j].x + v[j].y * v[j].y) + (v[j].z * v[j].z + v[j].w * v[j].w); }
    const float rstd = 1.0f / sqrtf(wave_sum(s) * (1.f / DM) + EPS);
#pragma unroll
    for (int j = 0; j < 8; ++j) { const f32x4 gg = gr[64 * j]; xr[64 * j] = v[j] * rstd * gg; }
}

__device__ __forceinline__ void h2_row(int L, int t, bf16_t* H2Brow, const float* w1, const float* b1, const float* w2, const float* b2, const float* fq, int lane) {
    float feat = 0.f;
    if (lane == 0) feat = (float)t / (float)(L - 1);
    else if (lane <= 32) { const int j = (lane - 1) & 15; const float fr = 1e-4f + (float)j * ((15.0f - 1e-4f) / 15.0f); const float turns = fr * (float)t / (float)L;
        feat = (lane <= 16) ? cos2pi(turns) : -sin2pi(turns); }
    const float fql = fq[lane];
    float a = b1[lane];
    for (int i = 0; i < 33; ++i) a += __shfl(feat, i) * w1[i * 64 + lane];
    const float h1 = sin2pi(fql * a * 0.15915494309189535f);
    float b = b2[lane];
    for (int k = 0; k < 64; ++k) b += __shfl(h1, k) * w2[k * 64 + lane];
    H2Brow[lane] = (bf16_t)f2bf(sin2pi(fql * b * 0.15915494309189535f));
    H2Brow[64 + lane] = 0; H2Brow[128 + lane] = 0; H2Brow[192 + lane] = 0;
}

__device__ __forceinline__ void qk_row(bf16_t* row, int t, const float* qn, const float* kn, int lane) {
    const int i = lane & 31, half = lane >> 5; const int e0 = half * 64 + i, e1 = e0 + 32;
    const float inv = __builtin_amdgcn_exp2f(-(float)i * (13.287712379549449f / 32.0f));
    const float pos = half ? (float)(t & 63) : (float)(t >> 6);
    const float turns = pos * inv * 0.15915494309189535f; const float c = cos2pi(turns), s = sin2pi(turns);
    const float gq0 = qn[e0], gq1 = qn[e1], gk0 = kn[e0], gk1 = kn[e1];
#pragma unroll
    for (int hh = 0; hh < 10; ++hh) { bf16_t* p = row + hh * 128;
        float x0 = bf2f(p[e0]), x1 = bf2f(p[e1]);
        const float rstd = 1.0f / sqrtf(wave_sum(x0 * x0 + x1 * x1) * (1.f / 128.f) + EPS);
        x0 *= rstd * (hh < 8 ? gq0 : gk0); x1 *= rstd * (hh < 8 ? gq1 : gk1);
        const float qs = hh < 8 ? 0.12751743082459868f : 1.0f;
        p[e0] = (bf16_t)f2bf((x0 * c - x1 * s) * qs); p[e1] = (bf16_t)f2bf((x1 * c + x0 * s) * qs); }
}
typedef float cf __attribute__((ext_vector_type(2)));
__device__ __forceinline__ cf cmul(cf a, cf b) {
    cf d;
    asm("v_pk_mul_f32 %0, %1, %2 op_sel:[0,0] op_sel_hi:[0,1]" : "=v"(d) : "v"(a), "v"(b));
    asm("v_pk_fma_f32 %0, %1, %2, %0 op_sel:[1,1,0] op_sel_hi:[1,0,1] neg_lo:[0,1,0]" : "+v"(d) : "v"(a), "v"(b));
    return d;
}
__device__ __forceinline__ cf twid(float turns, bool inv) {
    const float c = cos2pi(turns), s = sin2pi(turns);
    cf w = inv ? cf{c, s} : cf{c, -s};
    asm volatile("s_nop 1" : "+v"(w));
    return w;
}
__device__ __forceinline__ int fphys(int i) { return i + ((i >> 5) << 1); }
typedef float f32x2v __attribute__((ext_vector_type(2)));
__device__ __forceinline__ cf xld(const LAS cf* X, int i) { const f32x2v v = *(const LAS f32x2v*)(X + fphys(i)); return {v.x, v.y}; }
__device__ __forceinline__ void xst(LAS cf* X, int i, cf v) { *(LAS f32x2v*)(X + fphys(i)) = (f32x2v){v.x, v.y}; }
template <bool INV> __device__ __forceinline__ void bfly4(cf& a0, cf& a1, cf& a2, cf& a3) {
    const cf t0 = a0 + a2, t1 = a0 - a2, t2 = a1 + a3, t3 = a1 - a3;
    const cf mi3 = INV ? cf{-t3.y, t3.x} : cf{t3.y, -t3.x};
    a0 = t0 + t2; a2 = t0 - t2; a1 = t1 + mi3; a3 = t1 - mi3;
}
template <bool INV> __device__ __forceinline__ cf w16c(float c, float s) { return INV ? cf{c, -s} : cf{c, s}; }
template <bool INV> __device__ __forceinline__ void dft16(cf (&a)[16]) {
#pragma unroll
    for (int n0 = 0; n0 < 4; ++n0) bfly4<INV>(a[n0], a[n0 + 4], a[n0 + 8], a[n0 + 12]);
    const float C1 = 0.92387953251128674f, S1 = 0.38268343236508977f, R2 = 0.70710678118654752f;
    a[1 + 4]  = cmul(a[1 + 4],  w16c<INV>(C1, -S1));
    a[1 + 8]  = cmul(a[1 + 8],  w16c<INV>(R2, -R2));
    a[1 + 12] = cmul(a[1 + 12], w16c<INV>(S1, -C1));
    a[2 + 4]  = cmul(a[2 + 4],  w16c<INV>(R2, -R2));
    a[2 + 8]  = cmul(a[2 + 8],  w16c<INV>(0.f, -1.f));
    a[2 + 12] = cmul(a[2 + 12], w16c<INV>(-R2, -R2));
    a[3 + 4]  = cmul(a[3 + 4],  w16c<INV>(S1, -C1));
    a[3 + 8]  = cmul(a[3 + 8],  w16c<INV>(-R2, -R2));
    a[3 + 12] = cmul(a[3 + 12], w16c<INV>(-C1, S1));
#pragma unroll
    for (int k0 = 0; k0 < 4; ++k0) bfly4<INV>(a[4 * k0], a[4 * k0 + 1], a[4 * k0 + 2], a[4 * k0 + 3]);
}
#define O16(k) (4 * ((k) & 3) + ((k) >> 2))
template <int S, bool INV> __device__ __forceinline__ void stage16(LAS cf* X, const int N) {
    constexpr int q = S / 16; const int G = N >> 4;
    static_assert(q == 16 || q % 32 == 0, "stage16: q is 16 or a multiple of 32");
    int tid_ = threadIdx.x; asm volatile("" : "+v"(tid_));
#pragma unroll 1
    for (int g = tid_; g < G; g += NTHR) {
        const int blk = g / q, j = g % q;
        LAS f32x2v* pb = (LAS f32x2v*)X + (fphys(blk * S) + (q == 16 ? j : fphys(j)));
#define POFF(i) (q == 16 ? (16 * (i) + 2 * ((i) >> 1)) : (i) * (q + 2 * (q / 32)))
        cf a[16];
#pragma unroll
        for (int i = 0; i < 16; ++i) { const f32x2v v = pb[POFF(i)]; a[i] = cf{v.x, v.y}; }
        cf w[16];
        {
            w[1] = twid((float)j * (1.0f / (float)S), INV);
            w[2] = cmul(w[1], w[1]); w[3] = cmul(w[2], w[1]); w[4] = cmul(w[2], w[2]); w[5] = cmul(w[4], w[1]); w[6] = cmul(w[3], w[3]); w[7] = cmul(w[4], w[3]); w[8] = cmul(w[4], w[4]);
#pragma unroll
            for (int k = 9; k < 16; ++k) w[k] = cmul(w[8], w[k - 8]);
        }
        if constexpr (INV) {
#pragma unroll
            for (int k = 1; k < 16; ++k) a[k] = cmul(a[k], w[k]);
            dft16<true>(a);
#pragma unroll
            for (int n = 0; n < 16; ++n) pb[POFF(n)] = (f32x2v){a[O16(n)].x, a[O16(n)].y};
        } else {
            dft16<false>(a);
#pragma unroll
            for (int k = 0; k < 16; ++k) { cf o = a[O16(k)]; if (k > 0) o = cmul(o, w[k]); pb[POFF(k)] = (f32x2v){o.x, o.y}; }
        }
#undef POFF
    }
}
template <int R0, bool INV> __device__ __forceinline__ void stage_r0(LAS cf* X, const int N) {
    const int q = N / R0;
    int tid_ = threadIdx.x; asm volatile("" : "+v"(tid_));
#pragma unroll 1
    for (int j = tid_; j < q; j += NTHR) {
        const cf w1 = twid((float)j / (float)N, INV);
        if constexpr (R0 == 4) {
            cf a0 = xld(X, j), a1 = xld(X, j + q), a2 = xld(X, j + 2 * q), a3 = xld(X, j + 3 * q);
            const cf w2 = cmul(w1, w1), w3 = cmul(w2, w1);
            if constexpr (INV) { a1 = cmul(a1, w1); a2 = cmul(a2, w2); a3 = cmul(a3, w3); bfly4<true>(a0, a1, a2, a3); }
            else { bfly4<false>(a0, a1, a2, a3); a1 = cmul(a1, w1); a2 = cmul(a2, w2); a3 = cmul(a3, w3); }
            xst(X, j, a0); xst(X, j + q, a1); xst(X, j + 2 * q, a2); xst(X, j + 3 * q, a3);
        } else {
            cf a0 = xld(X, j), a1 = xld(X, j + q);
            if constexpr (INV) { a1 = cmul(a1, w1); xst(X, j, a0 + a1); xst(X, j + q, a0 - a1); }
            else { xst(X, j, a0 + a1); xst(X, j + q, cmul(a0 - a1, w1)); }
        }
    }
}
__device__ __forceinline__ void stage16_last_store(const LAS cf* X, const int N, f32x4* Kst) {
    const int G = N >> 4;
    int tid_ = threadIdx.x; asm volatile("" : "+v"(tid_));
#pragma unroll 1
    for (int g = tid_; g < G; g += NTHR) {
        const LAS f32x4* xp = (const LAS f32x4*)(X + fphys(16 * g));
        cf a[16];
#pragma unroll
        for (int i = 0; i < 8; ++i) { const f32x4 v = xp[i]; a[2 * i] = cf{v.x, v.y}; a[2 * i + 1] = cf{v.z, v.w}; }
        dft16<false>(a);
#pragma unroll
        for (int i = 0; i < 8; ++i) Kst[(unsigned)(i * G + g)] = (f32x4){a[2 * i].x, a[2 * i].y, a[2 * i + 1].x, a[2 * i + 1].y};
    }
}
__device__ __forceinline__ void stage16_last_inplace(LAS cf* X, const int N) {
    const int G = N >> 4;
    int tid_ = threadIdx.x; asm volatile("" : "+v"(tid_));
#pragma unroll 1
    for (int g = tid_; g < G; g += NTHR) {
        LAS f32x4* xp = (LAS f32x4*)(X + fphys(16 * g));
        cf a[16];
#pragma unroll
        for (int i = 0; i < 8; ++i) { const f32x4 v = xp[i]; a[2 * i] = cf{v.x, v.y}; a[2 * i + 1] = cf{v.z, v.w}; }
        dft16<false>(a);
#pragma unroll
        for (int i = 0; i < 8; ++i) { const cf u = a[O16(2 * i)], v = a[O16(2 * i + 1)]; xp[i] = (f32x4){u.x, u.y, v.x, v.y}; }
    }
}
__device__ __forceinline__ void split_store(const LAS cf* X, const int N, f32x4* K0st, f32x4* K1st) {
    const int G = N >> 4, R = G;
    const int sh = (N == 16384) ? 2 : 1;
    int tid_ = threadIdx.x; asm volatile("" : "+v"(tid_));
#pragma unroll 1
    for (int g = tid_; g < G; g += NTHR) {
        const int ka = g >> 8, kb = (g >> 4) & 15, kc = g & 15;
        const int rho = ka + ((kb + 16 * kc) << sh);
        const int rp = (R - rho) & (R - 1);
        const int ka2 = rp & ((1 << sh) - 1), rest = rp >> sh, kb2 = rest & 15, kc2 = rest >> 4;
        const int g2 = (ka2 << 8) + (kb2 << 4) + kc2;
        const LAS f32x4* xa = (const LAS f32x4*)(X + fphys(16 * g)); const LAS f32x4* xb = (const LAS f32x4*)(X + fphys(16 * g2));
        cf f[16], p[16];
#pragma unroll
        for (int i = 0; i < 8; ++i) { const f32x4 v = xa[i]; f[2 * i] = cf{v.x, v.y}; f[2 * i + 1] = cf{v.z, v.w}; const f32x4 w = xb[i]; p[2 * i] = cf{w.x, w.y}; p[2 * i + 1] = cf{w.z, w.w}; }
        cf k0[16], k1[16];
        const bool z = (rho == 0);
#pragma unroll
        for (int k = 0; k < 16; ++k) { const cf pa = p[15 - k], pb = p[(16 - k) & 15]; const cf pp = z ? pb : pa;
            const cf s = cf{f[k].x + pp.x, f[k].y - pp.y}, d = cf{f[k].x - pp.x, f[k].y + pp.y};
            k0[k] = cf{0.5f * s.x, 0.5f * s.y}; k1[k] = cf{0.5f * d.y, -0.5f * d.x}; }
#pragma unroll
        for (int i = 0; i < 8; ++i) { const cf u0 = k0[O16(2 * i)], v0 = k0[O16(2 * i + 1)], u1 = k1[O16(2 * i)], v1 = k1[O16(2 * i + 1)];
            K0st[(unsigned)(i * G + g)] = (f32x4){u0.x, u0.y, v0.x, v0.y}; K1st[(unsigned)(i * G + g)] = (f32x4){u1.x, u1.y, v1.x, v1.y}; }
    }
}
__device__ __forceinline__ void stage16_mid(LAS cf* X, const int N, const f32x4* Kst, const float sc) {
    const int G = N >> 4;
    int tid_ = threadIdx.x; asm volatile("" : "+v"(tid_));
#pragma unroll 1
    for (int g = tid_; g < G; g += NTHR) {
        LAS f32x4* xp = (LAS f32x4*)(X + fphys(16 * g));
        f32x4 kk[8];
#pragma unroll
        for (int i = 0; i < 8; ++i) kk[i] = Kst[(unsigned)(i * G + g)];
        cf a[16];
#pragma unroll
        for (int i = 0; i < 8; ++i) { const f32x4 v = xp[i]; a[2 * i] = cf{v.x, v.y}; a[2 * i + 1] = cf{v.z, v.w}; }
        dft16<false>(a);
#pragma unroll
        for (int i = 0; i < 8; ++i) { cf p0 = cmul(a[2 * i], cf{kk[i].x, kk[i].y}), p1 = cmul(a[2 * i + 1], cf{kk[i].z, kk[i].w}); a[2 * i] = cf{p0.x * sc, p0.y * sc}; a[2 * i + 1] = cf{p1.x * sc, p1.y * sc}; }
        cf b[16];
#pragma unroll
        for (int k = 0; k < 16; ++k) b[k] = a[O16(k)];
        dft16<true>(b);
#pragma unroll
        for (int i = 0; i < 8; ++i) { const cf u = b[O16(2 * i)], v = b[O16(2 * i + 1)]; xp[i] = (f32x4){u.x, u.y, v.x, v.y}; }
    }
}
__device__ __forceinline__ void fft_fwd_head(LAS cf* X, const int N) {
    if (N == 16384) stage_r0<4, false>(X, N); else stage_r0<2, false>(X, N);
    __syncthreads();
    stage16<4096, false>(X, N); __syncthreads();
    stage16<256, false>(X, N); __syncthreads();
}
__device__ __forceinline__ void fft_inv_tail(LAS cf* X, const int N) {
    stage16<256, true>(X, N); __syncthreads();
    stage16<4096, true>(X, N); __syncthreads();
    if (N == 16384) stage_r0<4, true>(X, N); else stage_r0<2, true>(X, N);
    __syncthreads();
}

#define VEL(v, e) ((v)[(e) >> 2][(e) & 3])
template <int R0> __device__ __forceinline__ void r0_fwd_store(LAS cf* X, const int N, int j0, const f32x4 (&ar)[R0 / 2][2], const f32x4 (&ai)[R0 / 2][2]) {
    constexpr int q = 4096; const float rN = 1.0f / (float)N; asm volatile("" : "+v"(j0));
#pragma unroll
    for (int e = 0; e < 8; e += 2) {
        cf y[R0][2];
#pragma unroll
        for (int h = 0; h < 2; ++h) { const int j = j0 + e + h; const cf w1 = twid((float)j * rN, false);
            if constexpr (R0 == 4) { const cf a0 = cf{VEL(ar[0], e + h), VEL(ai[0], e + h)}, a1 = cf{VEL(ar[1], e + h), VEL(ai[1], e + h)}; const cf m = cf{a1.y, -a1.x};
                const cf w2 = cmul(w1, w1), w3 = cmul(w2, w1);
                y[0][h] = a0 + a1; y[1][h] = cmul(a0 + m, w1); y[2][h] = cmul(a0 - a1, w2); y[3][h] = cmul(a0 - m, w3); }
            else { const cf a0 = cf{VEL(ar[0], e + h), VEL(ai[0], e + h)}; y[0][h] = a0; y[1][h] = cmul(a0, w1); } }
#pragma unroll
        for (int k = 0; k < R0; ++k) *(LAS f32x4*)(X + fphys(j0 + e + k * q)) = (f32x4){y[k][0].x, y[k][0].y, y[k][1].x, y[k][1].y};
    }
}
template <int R0> __device__ __forceinline__ void r0_inv_load(const LAS cf* X, const int N, int j0, f32x4 (&yr)[R0 / 2][2], f32x4 (&yi)[R0 / 2][2]) {
    constexpr int q = 4096; const float rN = 1.0f / (float)N; asm volatile("" : "+v"(j0));
#pragma unroll
    for (int e = 0; e < 8; e += 2) {
        f32x4 v[R0];
#pragma unroll
        for (int k = 0; k < R0; ++k) v[k] = *(const LAS f32x4*)(X + fphys(j0 + e + k * q));
#pragma unroll
        for (int h = 0; h < 2; ++h) { const int j = j0 + e + h; const cf w1 = twid((float)j * rN, true);
            if constexpr (R0 == 4) { const cf w2 = cmul(w1, w1), w3 = cmul(w2, w1);
                const cf a0 = h ? cf{v[0].z, v[0].w} : cf{v[0].x, v[0].y}; const cf a1 = cmul(h ? cf{v[1].z, v[1].w} : cf{v[1].x, v[1].y}, w1);
                const cf a2 = cmul(h ? cf{v[2].z, v[2].w} : cf{v[2].x, v[2].y}, w2); const cf a3 = cmul(h ? cf{v[3].z, v[3].w} : cf{v[3].x, v[3].y}, w3);
                const cf t0 = a0 + a2, t1 = a0 - a2, t2 = a1 + a3, t3 = a1 - a3;
                VEL(yr[0], e + h) = t0.x + t2.x; VEL(yi[0], e + h) = t0.y + t2.y; VEL(yr[1], e + h) = t1.x - t3.y; VEL(yi[1], e + h) = t1.y + t3.x; }
            else { const cf a0 = h ? cf{v[0].z, v[0].w} : cf{v[0].x, v[0].y}; const cf a1 = cmul(h ? cf{v[1].z, v[1].w} : cf{v[1].x, v[1].y}, w1);
                VEL(yr[0], e + h) = a0.x + a1.x; VEL(yi[0], e + h) = a0.y + a1.y; } }
    }
}
__device__ __forceinline__ void fft_mid_chain(LAS cf* X, const int N, const f32x4* Kst, const float sc) {
    __syncthreads();
    stage16<4096, false>(X, N); __syncthreads();
    stage16<256, false>(X, N); __syncthreads();
    stage16_mid(X, N, Kst, sc); __syncthreads();
    stage16<256, true>(X, N); __syncthreads();
    stage16<4096, true>(X, N); __syncthreads();
}
struct HyParams { const float *conv_w, *conv_b, *w3, *decay, *hbias; const bf16_t* hyT; bf16_t* hyo; };
__device__ __forceinline__ void conv8(const bf16_t* hyT, unsigned off, int t0, int L, float w0, float w1, float w2, float b, f32x4 (&o)[2]) {
    const u32x4v raw = *(const u32x4v*)(hyT + (off + (unsigned)t0));
    const float xm = t0 > 0 ? bf2f(hyT[off + (unsigned)t0 - 1u]) : 0.f, xp = t0 + 8 < L ? bf2f(hyT[off + (unsigned)t0 + 8u]) : 0.f;
    const float x0 = __uint_as_float(raw.x << 16), x1 = __uint_as_float(raw.x & 0xffff0000u), x2 = __uint_as_float(raw.y << 16), x3 = __uint_as_float(raw.y & 0xffff0000u);
    const float x4 = __uint_as_float(raw.z << 16), x5 = __uint_as_float(raw.z & 0xffff0000u), x6 = __uint_as_float(raw.w << 16), x7 = __uint_as_float(raw.w & 0xffff0000u);
    o[0][0] = fmaf(xm, w0, fmaf(x0, w1, fmaf(x1, w2, b))); o[0][1] = fmaf(x0, w0, fmaf(x1, w1, fmaf(x2, w2, b))); o[0][2] = fmaf(x1, w0, fmaf(x2, w1, fmaf(x3, w2, b))); o[0][3] = fmaf(x2, w0, fmaf(x3, w1, fmaf(x4, w2, b)));
    o[1][0] = fmaf(x3, w0, fmaf(x4, w1, fmaf(x5, w2, b))); o[1][1] = fmaf(x4, w0, fmaf(x5, w1, fmaf(x6, w2, b))); o[1][2] = fmaf(x5, w0, fmaf(x6, w1, fmaf(x7, w2, b))); o[1][3] = fmaf(x6, w0, fmaf(x7, w1, fmaf(xp, w2, b)));
}
__device__ __forceinline__ float block_sum(float v, LAS float* red) {
    v = wave_sum(v);
    __syncthreads();
    if ((threadIdx.x & 63) == 0) red[threadIdx.x >> 6] = v;
    __syncthreads();
    float s = 0.f;
#pragma unroll
    for (int i = 0; i < NWAVES; ++i) s += red[i];
    return s;
}
template <int R0> __device__ __forceinline__ void hy_pair(LAS cf* X, const int N, const int L, const int tid, const unsigned mA, const unsigned mB, const bf16_t* hyT, bf16_t* hyo,
        const unsigned ov, const unsigned oa, const unsigned ob, const f32x4* K0, const f32x4* K1, f32x4* ZS, const float sc0, const float sc1, const float d0, const float d1,
        const float wv0, const float wv1, const float wv2, const float bv, const float wa0, const float wa1, const float wa2, const float ba,
        const float wb0, const float wb1, const float wb2, const float bb) {
    constexpr int NL = R0 / 2; int j0 = 8 * tid; asm volatile("" : "+v"(j0));
    {   f32x4 vr[NL][2], vi[NL][2];
#pragma unroll
        for (int n = 0; n < NL; ++n) { conv8(hyT, ov + mA, j0 + n * 4096, L, wv0, wv1, wv2, bv, vr[n]); conv8(hyT, ov + mB, j0 + n * 4096, L, wv0, wv1, wv2, bv, vi[n]); }
        r0_fwd_store<R0>(X, N, j0, vr, vi); }
    fft_mid_chain(X, N, K0, sc0);
    {   f32x4 yr[NL][2], yi[NL][2]; r0_inv_load<R0>(X, N, j0, yr, yi);
#pragma unroll
        for (int n = 0; n < NL; ++n) { const int t0 = j0 + n * 4096; f32x4 va[2], vb[2], xa[2], xb[2];
            conv8(hyT, ov + mA, t0, L, wv0, wv1, wv2, bv, va); conv8(hyT, ov + mB, t0, L, wv0, wv1, wv2, bv, vb);
            conv8(hyT, oa + mA, t0, L, wa0, wa1, wa2, ba, xa); conv8(hyT, oa + mB, t0, L, wa0, wa1, wa2, ba, xb);
#pragma unroll
            for (int q4 = 0; q4 < 2; ++q4) { yr[n][q4] = xa[q4] * (yr[n][q4] + va[q4] * d0); yi[n][q4] = xb[q4] * (yi[n][q4] + vb[q4] * d0); }
#pragma unroll
            for (int e = 0; e < 8; e += 2) ZS[(unsigned)((t0 + e) >> 1)] = (f32x4){VEL(yr[n], e), VEL(yi[n], e), VEL(yr[n], e + 1), VEL(yi[n], e + 1)}; }
        r0_fwd_store<R0>(X, N, j0, yr, yi); }
    fft_mid_chain(X, N, K1, sc1);
    {   f32x4 yr[NL][2], yi[NL][2]; r0_inv_load<R0>(X, N, j0, yr, yi);
#pragma unroll
        for (int n = 0; n < NL; ++n) { const int t0 = j0 + n * 4096; f32x4 xa[2], xb[2];
            conv8(hyT, ob + mA, t0, L, wb0, wb1, wb2, bb, xa); conv8(hyT, ob + mB, t0, L, wb0, wb1, wb2, bb, xb);
            u32x4v oA, oB;
#pragma unroll
            for (int e = 0; e < 8; e += 2) { const f32x4 z = ZS[(unsigned)((t0 + e) >> 1)];
                oA[e >> 1] = pk2(VEL(xa, e) * (VEL(yr[n], e) + z.x * d1), VEL(xa, e + 1) * (VEL(yr[n], e + 1) + z.z * d1));
                oB[e >> 1] = pk2(VEL(xb, e) * (VEL(yi[n], e) + z.y * d1), VEL(xb, e + 1) * (VEL(yi[n], e + 1) + z.w * d1)); }
            *(u32x4v*)(hyo + (ov + mA + (unsigned)t0)) = oA; *(u32x4v*)(hyo + (ov + mB + (unsigned)t0)) = oB; } }
}
__device__ __forceinline__ void hyena_item(const int L, int c, int m_base, int nb, const float* FT, const HyParams& P, float* Kf, LAS unsigned char* lds) {
    const int N = 2 * L;
    LAS cf* X = (LAS cf*)lds; LAS float* coef = (LAS float*)(lds + LDS_COEF); LAS float* red = (LAS float*)(lds + LDS_RED);
    int tid = threadIdx.x; asm volatile("" : "+v"(tid));
    f32x4* K0 = (f32x4*)Kf; f32x4* K1 = (f32x4*)Kf + 8192; float* k1s = (float*)K1; f32x4* ZS = (f32x4*)Kf + 16384;
    __syncthreads();
    float s0 = 0.f, s1 = 0.f;
    const unsigned r00 = (unsigned)c * (unsigned)L, r01 = (unsigned)(1024 + c) * (unsigned)L, r10 = (unsigned)(2048 + c) * (unsigned)L, r11 = (unsigned)(3072 + c) * (unsigned)L;
#pragma unroll 2
    for (int j = 0; j < (L >> 11); ++j) { const int t0 = 4 * (tid + NTHR * j);
        const f32x4 fw0 = *(const f32x4*)(FT + (r00 + (unsigned)t0)), fw1 = *(const f32x4*)(FT + (r01 + (unsigned)t0));
        const f32x4 bw0 = *(const f32x4*)(FT + (r10 + (unsigned)t0)), bw1 = *(const f32x4*)(FT + (r11 + (unsigned)t0));
#pragma unroll
        for (int e = 0; e < 4; ++e) { const int t = t0 + e;
            s0 += fabsf(fw0[e]) + (t > 0 ? fabsf(bw0[e]) : 0.f); s1 += fabsf(fw1[e]) + (t > 0 ? fabsf(bw1[e]) : 0.f);
            if (t > 0) xst(X, N - t, cf{bw0[e], bw1[e]}); }
        *(LAS f32x4*)(X + fphys(t0)) = (f32x4){fw0[0], fw1[0], fw0[1], fw1[1]}; *(LAS f32x4*)(X + fphys(t0 + 2)) = (f32x4){fw0[2], fw1[2], fw0[3], fw1[3]}; }
    if (tid == 0) xst(X, L, cf{0.f, 0.f});
    s0 = block_sum(s0, red); s1 = block_sum(s1, red);
    const float sc0 = 1.0f / (s0 * (float)N), sc1 = 1.0f / (s1 * (float)N);
    __syncthreads();
    fft_fwd_head(X, N);
    stage16_last_inplace(X, N);
    __syncthreads();
    split_store(X, N, K0, K1);
    __syncthreads();
    const float wv0 = P.conv_w[c], wv1 = P.conv_w[NHY + c], wv2 = P.conv_w[2 * NHY + c], bv = P.conv_b[c];
    const float wa0 = P.conv_w[DH + c], wa1 = P.conv_w[NHY + DH + c], wa2 = P.conv_w[2 * NHY + DH + c], ba = P.conv_b[DH + c];
    const float wb0 = P.conv_w[2 * DH + c], wb1 = P.conv_w[NHY + 2 * DH + c], wb2 = P.conv_w[2 * NHY + 2 * DH + c], bb = P.conv_b[2 * DH + c];
    const float d0 = P.hbias[c], d1 = P.hbias[DH + c];
    const bf16_t* hyT = P.hyT; bf16_t* hyo = P.hyo;
    const unsigned ov = (unsigned)c * (unsigned)M_ALL, oa = (unsigned)(DH + c) * (unsigned)M_ALL, ob = (unsigned)(2 * DH + c) * (unsigned)M_ALL;
#pragma unroll 1
    for (int pr = 0; pr < nb / 2; ++pr) {
        const unsigned mA = (unsigned)(m_base + (2 * pr) * L), mB = mA + (unsigned)L;
        if (N == 16384) hy_pair<4>(X, N, L, tid, mA, mB, hyT, hyo, ov, oa, ob, K0, K1, ZS, sc0, sc1, d0, d1, wv0, wv1, wv2, bv, wa0, wa1, wa2, ba, wb0, wb1, wb2, bb);
        else hy_pair<2>(X, N, L, tid, mA, mB, hyT, hyo, ov, oa, ob, K0, K1, ZS, sc0, sc1, d0, d1, wv0, wv1, wv2, bv, wa0, wa1, wa2, ba, wb0, wb1, wb2, bb);
    }
}
constexpr int N_PHASES = 13;
__global__ void __launch_bounds__(NTHR, 2) fwd_kernel(Args args) {
    extern __shared__ __attribute__((aligned(16))) unsigned char lds_raw[];
    LAS unsigned char* lds = (LAS unsigned char*)lds_raw;
    const int tid = threadIdx.x, lane = tid & 63, wave = __builtin_amdgcn_readfirstlane(tid >> 6);
    const int G = gridDim.x, bx = blockIdx.x;
    const int vcu = (G % 8 == 0) ? (bx % 8) * (G / 8) + bx / 8 : bx;
    const int gw = vcu * NWAVES + wave, NGW = G * NWAVES;
    unsigned char* ws = args.ws;
    const float* x_p = args.in[0]; const float* x_s = args.in[1];
    const float* ffn1_norm = args.in[2]; const float* ffn1_w13 = args.in[3]; const float* ffn1_w2 = args.in[4];
    const float* mix_norm = args.in[5]; const float* w_in = args.in[6]; const float* q_norm = args.in[7]; const float* k_norm = args.in[8];
    const float* conv_w = args.in[9]; const float* conv_b = args.in[10];
    const float* filt_w1 = args.in[11]; const float* filt_b1 = args.in[12]; const float* filt_w2 = args.in[13]; const float* filt_b2 = args.in[14];
    const float* filt_w3 = args.in[15]; const float* filt_freq = args.in[16]; const float* hy_decay = args.in[17]; const float* hy_bias = args.in[18];
    const float* gon = args.in[19]; const float* w_out = args.in[20];
    const float* ffn2_norm = args.in[21]; const float* ffn2_w13 = args.in[22]; const float* ffn2_w2 = args.in[23]; const float* final_norm = args.in[24];
    float* out = args.out;
    bf16_t* W13A = (bf16_t*)(ws + WS_W13A); bf16_t* W2A = (bf16_t*)(ws + WS_W2A); bf16_t* WIN = (bf16_t*)(ws + WS_WIN); bf16_t* WOUT = (bf16_t*)(ws + WS_WOUT);
    bf16_t* W13B = (bf16_t*)(ws + WS_W13B); bf16_t* W2B = (bf16_t*)(ws + WS_W2B);
    bf16_t* XN = (bf16_t*)(ws + WS_XN); bf16_t* ACT = (bf16_t*)(ws + WS_ACT);
    bf16_t* QKV = (bf16_t*)(ws + WS_QKV); bf16_t* HYT = (bf16_t*)(ws + WS_HYT); bf16_t* HYO = (bf16_t*)(ws + WS_HYO);
    bf16_t* XN2 = (bf16_t*)(ws + WS_XN2);
    float* FTS = (float*)(ws + WS_FTS); float* FTP = (float*)(ws + WS_FTP); bf16_t* H2B = (bf16_t*)(ws + WS_H2B); bf16_t* W3T = (bf16_t*)(ws + WS_W3T);
    float* KSP = (float*)(ws + WS_KSP) + (size_t)bx * (2 * (2 * 16384 + 8192));
    const int lo = args.ph_lo, hi = args.ph_hi;
#ifndef PH_MASK
#define PH_MASK 0x1fff
#endif
#ifndef DUP_MASK
#define DUP_MASK 0
#endif
#define REP(k) for (int rep_ = 0; rep_ < 1 + ((DUP_MASK >> (k)) & 1); ++rep_)
#define IN(k) (((PH_MASK >> (k)) & 1) && lo <= (k) && (k) < hi)
#if MK_ONE_LAUNCH
#define SEAM(k) do { if (IN(k) && IN((k) + 1)) { cg::this_grid().sync(); } } while (0)
#else
#define SEAM(k) do { } while (0)
#endif

    if (IN(0)) REP(0) {
        LAS float* scr = (LAS float*)(lds + wave * 16384);
        constexpr int I13 = (DM / 64) * (2 * DFF / 32), I2 = (DFF / 64) * (DM / 32), IIN = (DM / 64) * (NIN / 32), IOUT = (DM / 64) * (DM / 32);
        constexpr int NITEMS = 2 * I13 + 2 * I2 + IIN + IOUT;
        for (int it = gw; it < NITEMS; it += NGW) {
            int r = it;
            if (r < 2 * I13) { const bool b = r >= I13; if (b) r -= I13; const int nblk = 2 * DFF / 32, kb = r / nblk, nb = r % nblk;
                transpose_item(b ? ffn2_w13 : ffn1_w13, DM, 2 * DFF, b ? W13B : W13A, 64 * kb, 32 * nb, swiglu_row(32 * nb), scr, lane); continue; }
            r -= 2 * I13;
            if (r < 2 * I2) { const bool b = r >= I2; if (b) r -= I2; const int nblk = DM / 32, kb = r / nblk, nb = r % nblk;
                transpose_item(b ? ffn2_w2 : ffn1_w2, DFF, DM, b ? W2B : W2A, 64 * kb, 32 * nb, 32 * nb, scr, lane); continue; }
            r -= 2 * I2;
            if (r < IIN) { const int nblk = NIN / 32, kb = r / nblk, nb = r % nblk; const int n0 = 32 * nb;
                if (n0 < 1280) { const int hh = n0 >> 7, d0 = n0 & 127; transpose_item(w_in, DM, NIN, WIN, 64 * kb, n0, hh * 128 + (d0 & 64) + ((d0 & 63) >> 5), scr, lane, 2); }
                else transpose_item(w_in, DM, NIN, WIN, 64 * kb, n0, n0, scr, lane);
                continue; }
            r -= IIN;
            { const int nblk = DM / 32, kb = r / nblk, nb = r % nblk; transpose_item(w_out, DM, DM, WOUT, 64 * kb, 32 * nb, 32 * nb, scr, lane); }
        }
        for (int m = gw; m < M_ALL; m += NGW) rms_row_bf16(m < M_P ? x_p + (size_t)m * DM : x_s + (size_t)(m - M_P) * DM, ffn1_norm, XN + (size_t)m * DM, lane);
        for (int i = vcu * NTHR + tid; i < 3 * 160 * 64; i += G * NTHR) ((unsigned*)(ws + WS_PCNT))[i] = 0u;
        for (int t = gw; t < L_S + L_P; t += NGW) h2_row(t < L_S ? L_S : L_P, t < L_S ? t : t - L_S, H2B + (size_t)t * 256, filt_w1, filt_b1, filt_w2, filt_b2, filt_freq, lane);
        for (int i = vcu * NTHR + tid; i < 4096 * 256; i += G * NTHR) { const int j = i >> 8, k = i & 255; W3T[i] = k < 64 ? (bf16_t)f2bf(filt_w3[(size_t)k * 4096 + j]) : (bf16_t)0; }
    }
    SEAM(0);
    if (IN(1)) REP(1) {
        pg8::Gemm g{XN, W13A, M_ALL, 2 * DFF, DM}; pg8::StaticOrder S; S.init(M_ALL, 2 * DFF, G, bx);
        pg8::EpiSwiGLU E{ACT, DFF};
        pg8::gemm_phase<pg8::EpiSwiGLU, pg8::StaticOrder, true, true>(lds, g, S, E);
    }
    SEAM(1);
    float* PART = (float*)(ws + WS_PART); unsigned* PCNT = (unsigned*)(ws + WS_PCNT);
    if (IN(2)) {
        { pg8::Gemm g{ACT, W2A, M_ALL, DM, DFF}; pg8::PanelOrder S{bx};
            pg8::EpiRmsX E{x_p, x_s, M_P, out, XN, DM, 0.5f, mix_norm, PART, PCNT + 160 * 64, lds + LDS_COEF};
            pg8::gemm_phase<pg8::EpiRmsX, pg8::PanelOrder, true, true>(lds, g, S, E); }
    }
    SEAM(2);
    if (IN(3)) { pg8::Gemm g{W3T, H2B, 4096, L_S + L_P, 256}; pg8::StaticOrder S; S.init(4096, L_S + L_P, G, bx);
        pg8::EpiFilt E{FTS, FTP, hy_decay};
        pg8::gemm_phase<pg8::EpiFilt, pg8::StaticOrder, true, true>(lds, g, S, E); }
    if (IN(4)) {
        { pg8::Gemm g{XN, WIN, M_ALL, NQKV, DM}; pg8::StaticOrder S; S.init(M_ALL, NQKV, G, bx);
          pg8::EpiQKV E{QKV, NQKV, q_norm, k_norm, lds + 131072};
          pg8::gemm_phase<pg8::EpiQKV, pg8::StaticOrder, true, true>(lds, g, S, E); }
        { pg8::Gemm g{WIN + (size_t)NQKV * DM, XN, NHY, M_ALL, DM}; pg8::StaticOrder S; S.init(NHY, M_ALL, G, bx);
          pg8::EpiBf16 E{HYT, M_ALL};
          pg8::gemm_phase<pg8::EpiBf16, pg8::StaticOrder, true, true>(lds, g, S, E); }
    }
    SEAM(4);
    if (IN(5)) {
        HyParams P{conv_w, conv_b, filt_w3, hy_decay, hy_bias, HYT, HYO};
        REP(5)
#pragma unroll 1
        for (int it = vcu; it < 2 * DH; it += G) { const bool smp = it < DH;
            hyena_item(smp ? L_S : L_P, smp ? it : it - DH, smp ? M_P : 0, smp ? 4 : 2, smp ? FTS : FTP, P, KSP, lds); }
    }
    if (IN(6)) REP(6) {
        __syncthreads();
        float mq = fmaxf(fabsf(q_norm[lane]), fabsf(q_norm[lane + 64])), mk = fmaxf(fabsf(k_norm[lane]), fabsf(k_norm[lane + 64]));
#pragma unroll
        for (int o_ = 1; o_ < 64; o_ <<= 1) { mq = fmaxf(mq, __shfl_xor(mq, o_)); mk = fmaxf(mk, __shfl_xor(mk, o_)); }
        const float negb = fmaxf(-16.65f * mq * mk, -60.0f);
#pragma unroll 1
        for (int uu = vcu; uu < 1280; uu += G) { const bool smp = uu < 1024; const int u = smp ? uu : uu - 1024;
            const int qb = smp ? (u & 31) : (u & 15), h = smp ? ((u >> 5) & 7) : ((u >> 4) & 7), b = smp ? (u >> 8) : (u >> 7);
            const int Ls = smp ? L_S : L_P; const unsigned r0 = smp ? (unsigned)(M_P + b * L_S) : (unsigned)(b * L_P);
            const bf16_t* kvb = QKV + (size_t)r0 * NQKV + 1024 + (h >> 2) * 128;
            attn::attn_dense_body(QKV + (size_t)(r0 + qb * 256) * NQKV + h * 128, kvb, kvb + 256, XN + (size_t)(r0 + qb * 256) * DM + h * 128, Ls, (char*)lds_raw, negb); }
    }
    SEAM(6);
    if (IN(7)) {
        for (int m = gw; m < M_ALL; m += NGW) { bf16_t* row = XN + (size_t)m * DM;
            u32x4v v0 = *((const u32x4v*)row + lane), v1 = *((const u32x4v*)row + 64 + lane); float s = 0.f; float f[16];
#pragma unroll
            for (int j = 0; j < 4; ++j) { f[2 * j] = __uint_as_float(v0[j] << 16); f[2 * j + 1] = __uint_as_float(v0[j] & 0xffff0000u); f[8 + 2 * j] = __uint_as_float(v1[j] << 16); f[8 + 2 * j + 1] = __uint_as_float(v1[j] & 0xffff0000u); }
#pragma unroll
            for (int j = 0; j < 16; ++j) s += f[j] * f[j];
            const float rstd = 1.0f / sqrtf(wave_sum(s) * (1.f / DH) + EPS);
            const float* g0 = gon + 8 * lane; const float* g1 = gon + 512 + 8 * lane;
#pragma unroll
            for (int j = 0; j < 4; ++j) { v0[j] = pk2(f[2 * j] * rstd * g0[2 * j], f[2 * j + 1] * rstd * g0[2 * j + 1]); v1[j] = pk2(f[8 + 2 * j] * rstd * g1[2 * j], f[8 + 2 * j + 1] * rstd * g1[2 * j + 1]); }
            *((u32x4v*)row + lane) = v0; *((u32x4v*)row + 64 + lane) = v1; }
        LAS unsigned* T = (LAS unsigned*)lds;
        for (int tile = vcu; tile < M_ALL / 64; tile += G) { const int m0 = tile * 64;
            __syncthreads();
            for (int i = 0; i < 16; ++i) { const int c = (tid >> 3) + 64 * i, ch = tid & 7; const u32x4v v = *(const u32x4v*)(HYO + (size_t)c * M_ALL + m0 + ch * 8);
                LAS unsigned* d = T + c * 33 + ch * 4; d[0] = v.x; d[1] = v.y; d[2] = v.z; d[3] = v.w; }
            __syncthreads();
            for (int tk = wave * 8; tk < wave * 8 + 8; ++tk) { float f[16]; float s = 0.f;
#pragma unroll
                for (int j = 0; j < 16; ++j) { const unsigned w = T[(lane + 64 * j) * 33 + (tk >> 1)]; f[j] = (tk & 1) ? __uint_as_float(w & 0xffff0000u) : __uint_as_float(w << 16); s += f[j] * f[j]; }
                const float rstd = 1.0f / sqrtf(wave_sum(s) * (1.f / DH) + EPS);
                bf16_t* orow = XN + (size_t)(m0 + tk) * DM + DH;
#pragma unroll
                for (int j = 0; j < 16; ++j) orow[lane + 64 * j] = (bf16_t)f2bf(f[j] * rstd * gon[DH + lane + 64 * j]); }
        }
    }
    SEAM(7);
    if (IN(8)) {
        { pg8::Gemm g{XN, WOUT, M_ALL, DM, DM}; pg8::PanelOrder S{bx};
            pg8::EpiRmsX E{out, out, 0, out, XN2, DM, 1.0f, ffn2_norm, PART, PCNT + 2 * 160 * 64, lds + LDS_COEF};
            pg8::gemm_phase<pg8::EpiRmsX, pg8::PanelOrder, true, true>(lds, g, S, E); }
    }
    SEAM(8);
    if (IN(10)) {
        pg8::Gemm g{XN2, W13B, M_ALL, 2 * DFF, DM}; pg8::StaticOrder S; S.init(M_ALL, 2 * DFF, G, bx);
        pg8::EpiSwiGLU E{ACT, DFF};
        pg8::gemm_phase<pg8::EpiSwiGLU, pg8::StaticOrder, true, true>(lds, g, S, E);
    }
    SEAM(10);
    if (IN(11)) {
        pg8::Gemm g{ACT, W2B, M_ALL, DM, DFF}; pg8::PanelOrder S{bx};
        pg8::EpiRmsFinal E{out, out, DM, 0.5f, final_norm, PART, PCNT, lds + LDS_COEF};
        pg8::gemm_phase<pg8::EpiRmsFinal, pg8::PanelOrder, true, true>(lds, g, S, E);
    }
#undef IN
#undef SEAM
}

extern "C" void kernel_launch(void* const* d_in, const int* in_sizes, int n_in, void* d_out, int out_size, void* d_ws, size_t ws_size, hipStream_t stream) {
    static int grid = 0;
    if (grid == 0) {
        if (n_in != 25 || out_size != M_ALL * DM || ws_size < WS_END) { fprintf(stderr, "kernel_launch: unexpected shapes n_in %d out %d ws %zu\n", n_in, out_size, ws_size); grid = -1; return; }
        int dev = 0, cus = 0, per_cu = 0;
        hipGetDevice(&dev); hipDeviceGetAttribute(&cus, hipDeviceAttributeMultiprocessorCount, dev);
        if (hipFuncSetAttribute((const void*)fwd_kernel, hipFuncAttributeMaxDynamicSharedMemorySize, LDS_BYTES) != hipSuccess) { fprintf(stderr, "kernel_launch: hipFuncSetAttribute failed\n"); grid = -1; return; }
        if (hipOccupancyMaxActiveBlocksPerMultiprocessor(&per_cu, (const void*)fwd_kernel, NTHR, LDS_BYTES) != hipSuccess || per_cu < 1) { fprintf(stderr, "kernel_launch: occupancy query says %d\n", per_cu); per_cu = 1; }
        (void)hipGetLastError();
        grid = cus * 1;
        if (grid != 256) { fprintf(stderr, "kernel_launch: this kernel is built for a 256-CU device (got %d CUs); nothing launched\n", cus); grid = -1; return; }
        fprintf(stderr, "kernel_launch: grid %d (cus %d, per_cu %d)\n", grid, cus, per_cu);
    }
    if (grid < 0) return;
    Args a{};
    for (int i = 0; i < 25; ++i) a.in[i] = (const float*)d_in[i];
    a.out = (float*)d_out; a.ws = (unsigned char*)d_ws;
#if MK_ONE_LAUNCH
    a.ph_lo = 0; a.ph_hi = N_PHASES;
    void* kargs[] = {&a};
    hipError_t e = hipLaunchCooperativeKernel((const void*)fwd_kernel, dim3(grid), dim3(NTHR), kargs, LDS_BYTES, stream);
    if (e != hipSuccess) fprintf(stderr, "kernel_launch: cooperative launch failed: %s (grid %d)\n", hipGetErrorString(e), grid);
#else
    for (int p = 0; p < N_PHASES; ++p) { a.ph_lo = p; a.ph_hi = p + 1;
        hipLaunchKernelGGL(fwd_kernel, dim3(grid), dim3(NTHR), LDS_BYTES, stream, a);
        const hipError_t le = hipPeekAtLastError(); if (le != hipSuccess) { fprintf(stderr, "kernel_launch: launch %d failed: %s\n", p, hipGetErrorName(le)); break; } }
#endif
}
```

```cpp
#include <hip/hip_runtime.h>
#include <hip/hip_bf16.h>
#include <hip/hip_cooperative_groups.h>
#include <cstdio>
#include <cstdint>
#include <cmath>
namespace cg = cooperative_groups;
#ifndef MK_ONE_LAUNCH
#define MK_ONE_LAUNCH 1
#endif
namespace pg8 {
#define PG8_LAS __attribute__((address_space(3)))
typedef unsigned short bf16_t;
typedef short bf16x8 __attribute__((ext_vector_type(8)));
typedef float f32x4 __attribute__((ext_vector_type(4)));
typedef unsigned u32x4 __attribute__((ext_vector_type(4)));
constexpr int BM = 256, BK = 64, HALF = 128, HTB = HALF * BK * 2  , STAGE_BYTES = 8 * HTB, NXCD = 8, WGM = 8;

__host__ __device__ __forceinline__ int lds_byte(int r, int c) { const int st = (r >> 4) * 2 + (c >> 5), rr = r & 15, cc = c & 31, ob = rr * 64 + cc * 2; return st * 1024 + (ob ^ (((ob >> 9) & 1) << 5)); }
__host__ __device__ __forceinline__ void stage_rc(int b, int& R, int& C) { const int st = b / 1024, sb = b % 1024, swz = sb ^ (((sb >> 9) & 1) << 5); R = (st >> 1) * 16 + swz / 64; C = (st & 1) * 32 + (swz % 64) / 2; }
__host__ __device__ __forceinline__ int perm32(int rho) { const int n = rho >> 4, i = rho & 15; return 8 * (i >> 2) + 4 * n + (i & 3); }

struct Unit { int pm, pn; };
struct Gemm { const bf16_t* A; const bf16_t* Bt; int M, N, K; };

struct StaticOrder {
    int nM, nN, nwg, G, c;
    __host__ __device__ void init(int M, int N, int G_, int c_) { nM = M / BM; nN = N / BM; nwg = nM * nN; G = G_; c = c_; }
    __host__ __device__ bool next(int i, Unit& u) const {
        const long L = (long)i * G + c; if (L >= nwg) return false;
        int wgid = (int)L; { const int q = nwg / NXCD, r = nwg % NXCD, xcd = wgid % NXCD, off = wgid / NXCD; wgid = (xcd < r ? xcd * (q + 1) : r * (q + 1) + (xcd - r) * q) + off; }
        const int nig = WGM * nN, gid = wgid / nig, fm = gid * WGM, gsz = (nM - fm) < WGM ? (nM - fm) : WGM;
        u.pm = fm + ((wgid % nig) % gsz); u.pn = (wgid % nig) / gsz; return true;
    }
    __device__ __forceinline__ void a_ready(const Unit&) const {}
    __device__ __forceinline__ void done(const Unit&) const {}
};
__device__ __forceinline__ unsigned cvt_pk_bf16(float lo, float hi) { unsigned r; asm volatile("v_cvt_pk_bf16_f32 %0, %1, %2" : "=v"(r) : "v"(lo), "v"(hi)); return r; }
typedef float f32x2 __attribute__((ext_vector_type(2)));
__device__ __forceinline__ float silu_f(float x) { return x * __builtin_amdgcn_rcpf(1.0f + __builtin_amdgcn_exp2f(-1.4426950408889634f * x)); }
struct EpiBf16 {
    static constexpr bool PERM = true, AFTER_DRAIN = false;
    bf16_t* O; int ldc;
    __device__ __forceinline__ void operator()(const f32x4 (&acc)[2][2][4][2], const Unit& u, int wr, int wc, int fr, int fq) const {
        const int row0 = u.pm * BM + wr * 64 + fr; const int col0 = u.pn * BM + wc * 32 + 8 * fq;
#pragma unroll
        for (int ai = 0; ai < 2; ++ai)
#pragma unroll
            for (int m = 0; m < 4; ++m) { bf16_t* rowp = O + (size_t)(row0 + ai * HALF + m * 16) * ldc + col0;
#pragma unroll
                for (int bj = 0; bj < 2; ++bj) { const f32x4 v0 = acc[ai][bj][m][0], v1 = acc[ai][bj][m][1];
                    u32x4 w; w.x = cvt_pk_bf16(v0[0], v0[1]); w.y = cvt_pk_bf16(v0[2], v0[3]); w.z = cvt_pk_bf16(v1[0], v1[1]); w.w = cvt_pk_bf16(v1[2], v1[3]);
                    *(u32x4*)(rowp + bj * HALF) = w; } }
    }
};
struct EpiSwiGLU {
    static constexpr bool PERM = true, AFTER_DRAIN = false;
    bf16_t* O; int ldc;
    __device__ __forceinline__ void operator()(const f32x4 (&acc)[2][2][4][2], const Unit& u, int wr, int wc, int fr, int fq) const {
        const int row0 = u.pm * BM + wr * 64 + fr; const int col0 = u.pn * HALF + wc * 32 + 8 * fq;
#pragma unroll
        for (int ai = 0; ai < 2; ++ai)
#pragma unroll
            for (int m = 0; m < 4; ++m) { bf16_t* rowp = O + (size_t)(row0 + ai * HALF + m * 16) * ldc + col0;
                const f32x4 g0 = acc[ai][0][m][0], g1 = acc[ai][0][m][1], u0 = acc[ai][1][m][0], u1 = acc[ai][1][m][1];
                u32x4 w;
                w.x = cvt_pk_bf16(silu_f(g0[0]) * u0[0], silu_f(g0[1]) * u0[1]); w.y = cvt_pk_bf16(silu_f(g0[2]) * u0[2], silu_f(g0[3]) * u0[3]);
                w.z = cvt_pk_bf16(silu_f(g1[0]) * u1[0], silu_f(g1[1]) * u1[1]); w.w = cvt_pk_bf16(silu_f(g1[2]) * u1[2], silu_f(g1[3]) * u1[3]);
                *(u32x4*)rowp = w; }
    }
};
struct EpiResid {
    static constexpr bool PERM = false, AFTER_DRAIN = false;
    const float* base0; const float* base1; int split; float* out; int ldc; float alpha;
    __device__ __forceinline__ void operator()(const f32x4 (&acc)[2][2][4][2], const Unit& u, int wr, int wc, int fr, int fq) const {
        const int row0 = u.pm * BM + wr * 64 + fr; const int col0 = u.pn * BM + wc * 32 + 4 * fq;
        const float* bs = (u.pm * BM < split) ? base0 : base1 - (size_t)split * ldc;
#pragma unroll
        for (int ai = 0; ai < 2; ++ai)
#pragma unroll
            for (int m = 0; m < 4; ++m) { const size_t off = (size_t)(row0 + ai * HALF + m * 16) * ldc + col0;
#pragma unroll
                for (int bj = 0; bj < 2; ++bj)
#pragma unroll
                    for (int n = 0; n < 2; ++n) { const f32x4 b = *(const f32x4*)(bs + off + bj * HALF + n * 16);
                        *(f32x4*)(out + off + bj * HALF + n * 16) = b + acc[ai][bj][m][n] * alpha; }
                if (m & 1) asm volatile("" ::: "memory"); }
    }
};
struct EpiFilt {
    static constexpr bool PERM = false, AFTER_DRAIN = false;
    float* Ts; float* Tp; const float* decay;
    __device__ __forceinline__ void operator()(const f32x4 (&acc)[2][2][4][2], const Unit& u, int wr, int wc, int fr, int fq) const {
        const int row0 = u.pm * BM + wr * 64 + fr; const int colt = u.pn * BM; const bool smp = colt < 8192;
        const int L = smp ? 8192 : 4096; float* T = smp ? Ts : Tp; const float rl1 = -1.4426950408889634f / (float)(L - 1);
        const int col0 = (smp ? colt : colt - 8192) + wc * 32 + 4 * fq;
#pragma unroll
        for (int ai = 0; ai < 2; ++ai)
#pragma unroll
            for (int m = 0; m < 4; ++m) { const int j = row0 + ai * HALF + m * 16; const float a = fabsf(decay[j]) * rl1; float* rowp = T + (size_t)j * L + col0;
#pragma unroll
                for (int bj = 0; bj < 2; ++bj)
#pragma unroll
                    for (int n = 0; n < 2; ++n) { const int t = col0 + bj * HALF + n * 16; f32x4 v = acc[ai][bj][m][n];
                        v[0] *= __builtin_amdgcn_exp2f((float)t * a); v[1] *= __builtin_amdgcn_exp2f((float)(t + 1) * a); v[2] *= __builtin_amdgcn_exp2f((float)(t + 2) * a); v[3] *= __builtin_amdgcn_exp2f((float)(t + 3) * a);
                        *(f32x4*)(rowp + bj * HALF + n * 16) = v; } }
    }
};
struct EpiQKV {
    static constexpr bool PERM = true, AFTER_DRAIN = false;
    bf16_t* O; int ldc; const float* qn; const float* kn; PG8_LAS unsigned char* xl;
    __device__ __forceinline__ void operator()(f32x4 (&acc)[2][2][4][2], const Unit& u, int wr, int wc, int fr, int fq) const {
        const int row0 = u.pm * BM + wr * 64 + fr; const int col0 = u.pn * BM + wc * 32 + 8 * fq;
        if (u.pn < 5) {
            PG8_LAS float* P = (PG8_LAS float*)xl; PG8_LAS float* S = P + 2048;
            int tid = threadIdx.x; asm volatile("" : "+v"(tid), "+v"(fr));
#pragma unroll
            for (int ai = 0; ai < 2; ++ai)
#pragma unroll
                for (int m = 0; m < 4; ++m)
#pragma unroll
                    for (int bj = 0; bj < 2; ++bj) { const f32x4 a = acc[ai][bj][m][0], b = acc[ai][bj][m][1];
                        float s = ((a[0] * a[0] + a[1] * a[1]) + (a[2] * a[2] + a[3] * a[3])) + ((b[0] * b[0] + b[1] * b[1]) + (b[2] * b[2] + b[3] * b[3]));
                        s += __shfl_xor(s, 16); s += __shfl_xor(s, 32);
                        if (fq == 0) P[((ai * HALF + wr * 64 + m * 16 + fr) * 2 + bj) * 4 + wc] = s; }
            asm volatile("s_waitcnt lgkmcnt(0)" ::: "memory"); __builtin_amdgcn_s_barrier(); asm volatile("" ::: "memory");
            { const f32x4 p = *(const PG8_LAS f32x4*)(P + 4 * tid); S[tid] = 1.0f / sqrtf(((p[0] + p[1]) + (p[2] + p[3])) * (1.0f / 128.0f) + 1e-6f); }
            asm volatile("s_waitcnt lgkmcnt(0)" ::: "memory"); __builtin_amdgcn_s_barrier(); asm volatile("" ::: "memory");
            const float* gn = (u.pn < 4) ? qn : kn; const float qs = (u.pn < 4) ? 0.12751743082459868f : 1.0f;
            asm volatile("" : "+v"(fq));
            const int h64 = (wc >> 1) * 64;
            float inv[4], g1[4], g2[4];
#pragma unroll
            for (int pr = 0; pr < 4; ++pr) { const int i = 16 * (wc & 1) + 4 * fq + pr;
                inv[pr] = __builtin_amdgcn_exp2f(-(float)i * (13.287712379549449f / 32.0f)) * 0.15915494309189535f; g1[pr] = gn[h64 + i] * qs; g2[pr] = gn[h64 + 32 + i] * qs; }
#pragma unroll
            for (int ai = 0; ai < 2; ++ai)
#pragma unroll
                for (int m = 0; m < 4; ++m) { const int rl = ai * HALF + wr * 64 + m * 16 + fr, row = u.pm * BM + rl;
                    const int t = row < 8192 ? (row & 4095) : ((row - 8192) & 8191); const float pos = h64 ? (float)(t & 63) : (float)(t >> 6);
                    float c[4], sn[4];
#pragma unroll
                    for (int pr = 0; pr < 4; ++pr) { const float turns = pos * inv[pr]; c[pr] = __builtin_amdgcn_cosf(turns); sn[pr] = __builtin_amdgcn_sinf(turns); }
                    bf16_t* rowp = O + (size_t)row * ldc + col0;
#pragma unroll
                    for (int bj = 0; bj < 2; ++bj) { const float rs = S[rl * 2 + bj]; const f32x4 a = acc[ai][bj][m][0], b = acc[ai][bj][m][1];
                        const float x0 = a[0] * rs * g1[0], y0 = a[1] * rs * g2[0], x1 = a[2] * rs * g1[1], y1 = a[3] * rs * g2[1];
                        const float x2 = b[0] * rs * g1[2], y2 = b[1] * rs * g2[2], x3 = b[2] * rs * g1[3], y3 = b[3] * rs * g2[3];
                        u32x4 w; w.x = cvt_pk_bf16(x0 * c[0] - y0 * sn[0], y0 * c[0] + x0 * sn[0]); w.y = cvt_pk_bf16(x1 * c[1] - y1 * sn[1], y1 * c[1] + x1 * sn[1]);
                        w.z = cvt_pk_bf16(x2 * c[2] - y2 * sn[2], y2 * c[2] + x2 * sn[2]); w.w = cvt_pk_bf16(x3 * c[3] - y3 * sn[3], y3 * c[3] + x3 * sn[3]);
                        *(u32x4*)(rowp + bj * HALF) = w; } }
            asm volatile("s_waitcnt lgkmcnt(0)" ::: "memory"); __builtin_amdgcn_s_barrier(); asm volatile("" ::: "memory");
        } else {
#pragma unroll
            for (int ai = 0; ai < 2; ++ai)
#pragma unroll
                for (int m = 0; m < 4; ++m) { bf16_t* rowp = O + (size_t)(row0 + ai * HALF + m * 16) * ldc + col0;
#pragma unroll
                    for (int bj = 0; bj < 2; ++bj) { const f32x4 v0 = acc[ai][bj][m][0], v1 = acc[ai][bj][m][1];
                        u32x4 w; w.x = cvt_pk_bf16(v0[0], v0[1]); w.y = cvt_pk_bf16(v0[2], v0[3]); w.z = cvt_pk_bf16(v1[0], v1[1]); w.w = cvt_pk_bf16(v1[2], v1[3]);
                        *(u32x4*)(rowp + bj * HALF) = w; } }
            asm volatile("s_waitcnt lgkmcnt(0)" ::: "memory"); __builtin_amdgcn_s_barrier(); __builtin_amdgcn_s_barrier(); __builtin_amdgcn_s_barrier();
        }
    }
};
struct PanelOrder {
    int c;
    __device__ __forceinline__ bool next(int i, Unit& u) const { if (i >= 5) return false; const int x = c & 7, k = c >> 3; u.pm = 32 * i + 4 * x + (k >> 3); u.pn = k & 7; return true; }
    __device__ __forceinline__ void a_ready(const Unit&) const {}
    __device__ __forceinline__ void done(const Unit&) const {}
};
struct EpiRmsFinal {
    static constexpr bool PERM = false, AFTER_DRAIN = false;
    const float* base; float* out; int ldc; float alpha; const float* g; float* part; unsigned* cnt; PG8_LAS unsigned char* xl;
    __device__ __forceinline__ void operator()(f32x4 (&acc)[2][2][4][2], const Unit& u, int wr, int wc, int fr, int fq) const {
        PG8_LAS float* P = (PG8_LAS float*)xl; PG8_LAS float* S = P + 1024; PG8_LAS unsigned* flag = (PG8_LAS unsigned*)(S + 256);
        const int tid = threadIdx.x, lane = tid & 63, wid = tid >> 6;
        const int row0 = u.pm * BM + wr * 64 + fr; const int col0 = u.pn * BM + wc * 32 + 4 * fq;
#pragma unroll
        for (int ai = 0; ai < 2; ++ai)
#pragma unroll
            for (int m = 0; m < 4; ++m) { const size_t off = (size_t)(row0 + ai * HALF + m * 16) * ldc + col0; float s = 0.f;
#pragma unroll
                for (int bj = 0; bj < 2; ++bj)
#pragma unroll
                    for (int n = 0; n < 2; ++n) { const f32x4 b = *(const f32x4*)(base + off + bj * HALF + n * 16); const f32x4 v = b + acc[ai][bj][m][n] * alpha; acc[ai][bj][m][n] = v;
                        s += (v[0] * v[0] + v[1] * v[1]) + (v[2] * v[2] + v[3] * v[3]); }
                s += __shfl_xor(s, 16); s += __shfl_xor(s, 32);
                if (fq == 0) P[(ai * HALF + wr * 64 + m * 16 + fr) * 4 + wc] = s;
                if (m & 1) asm volatile("" ::: "memory"); }
        asm volatile("s_waitcnt lgkmcnt(0)" ::: "memory"); __builtin_amdgcn_s_barrier(); asm volatile("" ::: "memory");
        const int row = wid * 32 + (lane & 31);
        float* prow = part + ((size_t)(u.pm * BM + row)) * 8;
        if (lane < 32) { const float tot = (P[row * 4] + P[row * 4 + 1]) + (P[row * 4 + 2] + P[row * 4 + 3]); __hip_atomic_store(prow + u.pn, tot, __ATOMIC_RELAXED, __HIP_MEMORY_SCOPE_AGENT); }
        asm volatile("s_waitcnt vmcnt(0)" ::: "memory");
        if (lane == 0) __hip_atomic_fetch_add(cnt + 64 * u.pm, 1u, __ATOMIC_RELAXED, __HIP_MEMORY_SCOPE_AGENT);
        if (wid == 0) { unsigned polls = 0;
            while ((unsigned)__builtin_amdgcn_readfirstlane(__hip_atomic_load(cnt + 64 * u.pm, __ATOMIC_RELAXED, __HIP_MEMORY_SCOPE_AGENT)) < 64u) { __builtin_amdgcn_s_sleep(2); if (++polls > (1u << 22)) break; }
            (void)flag; }
        asm volatile("s_waitcnt vmcnt(0) lgkmcnt(0)" ::: "memory"); __builtin_amdgcn_s_barrier(); asm volatile("" ::: "memory");
        if (lane < 32) { float t = 0.f;
#pragma unroll
            for (int j = 0; j < 8; ++j) t += __hip_atomic_load(prow + j, __ATOMIC_RELAXED, __HIP_MEMORY_SCOPE_AGENT);
            S[row] = 1.0f / sqrtf(t * (1.0f / 2048.0f) + 1e-6f); }
        asm volatile("s_waitcnt lgkmcnt(0)" ::: "memory"); __builtin_amdgcn_s_barrier(); asm volatile("" ::: "memory");
#pragma unroll
        for (int ai = 0; ai < 2; ++ai)
#pragma unroll
            for (int m = 0; m < 4; ++m) { const int r = ai * HALF + wr * 64 + m * 16 + fr; const float rs = S[r]; const size_t off = (size_t)(u.pm * BM + r) * ldc + col0;
#pragma unroll
                for (int bj = 0; bj < 2; ++bj)
#pragma unroll
                    for (int n = 0; n < 2; ++n) { const f32x4 gg = *(const f32x4*)(g + col0 + bj * HALF + n * 16); *(f32x4*)(out + off + bj * HALF + n * 16) = acc[ai][bj][m][n] * rs * gg; } }
        asm volatile("s_waitcnt lgkmcnt(0)" ::: "memory"); __builtin_amdgcn_s_barrier(); asm volatile("" ::: "memory");
    }
};
struct EpiRmsX {
    static constexpr bool PERM = false, AFTER_DRAIN = false;
    const float* base0; const float* base1; int split; float* out; bf16_t* xn; int ldc; float alpha; const float* g; float* part; unsigned* cnt; PG8_LAS unsigned char* xl;
    __device__ __forceinline__ void operator()(f32x4 (&acc)[2][2][4][2], const Unit& u, int wr, int wc, int fr, int fq) const {
        PG8_LAS float* P = (PG8_LAS float*)xl; PG8_LAS float* S = P + 1024; PG8_LAS unsigned* flag = (PG8_LAS unsigned*)(S + 256);
        const int tid = threadIdx.x, lane = tid & 63, wid = tid >> 6;
        const int row0 = u.pm * BM + wr * 64 + fr; const int col0 = u.pn * BM + wc * 32 + 4 * fq;
        const float* base = (u.pm * BM < split) ? base0 : base1 - (size_t)split * ldc;
#pragma unroll
        for (int ai = 0; ai < 2; ++ai)
#pragma unroll
            for (int m = 0; m < 4; ++m) { const size_t off = (size_t)(row0 + ai * HALF + m * 16) * ldc + col0; float s = 0.f;
#pragma unroll
                for (int bj = 0; bj < 2; ++bj)
#pragma unroll
                    for (int n = 0; n < 2; ++n) { const f32x4 b = *(const f32x4*)(base + off + bj * HALF + n * 16); const f32x4 v = b + acc[ai][bj][m][n] * alpha; acc[ai][bj][m][n] = v; *(f32x4*)(out + off + bj * HALF + n * 16) = v;
                        s += (v[0] * v[0] + v[1] * v[1]) + (v[2] * v[2] + v[3] * v[3]); }
                s += __shfl_xor(s, 16); s += __shfl_xor(s, 32);
                if (fq == 0) P[(ai * HALF + wr * 64 + m * 16 + fr) * 4 + wc] = s;
                if (m & 1) asm volatile("" ::: "memory"); }
        asm volatile("s_waitcnt lgkmcnt(0)" ::: "memory"); __builtin_amdgcn_s_barrier(); asm volatile("" ::: "memory");
        const int row = wid * 32 + (lane & 31);
        float* prow = part + ((size_t)(u.pm * BM + row)) * 8;
        if (lane < 32) { const float tot = (P[row * 4] + P[row * 4 + 1]) + (P[row * 4 + 2] + P[row * 4 + 3]); __hip_atomic_store(prow + u.pn, tot, __ATOMIC_RELAXED, __HIP_MEMORY_SCOPE_AGENT); }
        asm volatile("s_waitcnt vmcnt(0)" ::: "memory");
        if (lane == 0) __hip_atomic_fetch_add(cnt + 64 * u.pm, 1u, __ATOMIC_RELAXED, __HIP_MEMORY_SCOPE_AGENT);
        if (wid == 0) { unsigned polls = 0;
            while ((unsigned)__builtin_amdgcn_readfirstlane(__hip_atomic_load(cnt + 64 * u.pm, __ATOMIC_RELAXED, __HIP_MEMORY_SCOPE_AGENT)) < 64u) { __builtin_amdgcn_s_sleep(2); if (++polls > (1u << 22)) break; }
            (void)flag; }
        asm volatile("s_waitcnt vmcnt(0) lgkmcnt(0)" ::: "memory"); __builtin_amdgcn_s_barrier(); asm volatile("" ::: "memory");
        if (lane < 32) { float t = 0.f;
#pragma unroll
            for (int j = 0; j < 8; ++j) t += __hip_atomic_load(prow + j, __ATOMIC_RELAXED, __HIP_MEMORY_SCOPE_AGENT);
            S[row] = 1.0f / sqrtf(t * (1.0f / 2048.0f) + 1e-6f); }
        asm volatile("s_waitcnt lgkmcnt(0)" ::: "memory"); __builtin_amdgcn_s_barrier(); asm volatile("" ::: "memory");
#pragma unroll
        for (int ai = 0; ai < 2; ++ai)
#pragma unroll
            for (int m = 0; m < 4; ++m) { const int r = ai * HALF + wr * 64 + m * 16 + fr; const float rs = S[r]; const size_t off = (size_t)(u.pm * BM + r) * ldc + col0;
#pragma unroll
                for (int bj = 0; bj < 2; ++bj)
#pragma unroll
                    for (int n = 0; n < 2; ++n) { const f32x4 gg = *(const f32x4*)(g + col0 + bj * HALF + n * 16); const f32x4 y = acc[ai][bj][m][n] * rs * gg; typedef unsigned u32x2_t __attribute__((ext_vector_type(2))); u32x2_t w; w.x = cvt_pk_bf16(y[0], y[1]); w.y = cvt_pk_bf16(y[2], y[3]); *(u32x2_t*)(xn + off + bj * HALF + n * 16) = w; } }
        asm volatile("s_waitcnt lgkmcnt(0)" ::: "memory"); __builtin_amdgcn_s_barrier(); asm volatile("" ::: "memory");
    }
};
template <class Epi, class Sched, bool ALIGN_EPI = false, bool SP2 = false>
__device__ __forceinline__ void gemm_phase(PG8_LAS unsigned char* lds, const Gemm g, const Sched& S, const Epi& E) {
    const int tid = threadIdx.x, wid = __builtin_amdgcn_readfirstlane(tid >> 6), lane = tid & 63, wr = wid >> 2, wc = wid & 3, fr = lane & 15, fq = lane >> 4;
    const int K = g.K, nt = K / BK;
    unsigned voffA[2], voffB[2];
#pragma unroll
    for (int i = 0; i < 2; ++i) { int R, C; stage_rc(tid * 16 + i * 8192, R, C); const int Rb = Epi::PERM ? ((R & ~31) + perm32(R & 31)) : R;
        voffA[i] = (unsigned)(R * K + C) * 2u; voffB[i] = (unsigned)(Rb * K + C) * 2u; }
    const size_t kstep = (size_t)(BK * 2);
    const size_t hstep = (size_t)HALF * K * 2;
    const size_t tstep = 2 * hstep;
    const unsigned ldsw = (unsigned)wid * 1024u;
    const int aoff = lds_byte(wr * 64 + fr, fq * 8), boff = lds_byte(wc * 32 + fr, fq * 8);
#define PG8_SA(b, h) (((b) * 2 + (h)) * HTB)
#define PG8_SB(b, h) ((4 + (b) * 2 + (h)) * HTB)
#define PG8_STAGE(bufoff, gbase, voff) do { _Pragma("unroll") for (int _i = 0; _i < 2; ++_i) \
        __builtin_amdgcn_global_load_lds((const unsigned*)((const char*)(gbase) + (voff)[_i]), (PG8_LAS unsigned*)(lds + (bufoff) + ldsw + _i * 8192), 16, 0, 0); } while (0)
#define PG8_LDA(dst, b, h) do { _Pragma("unroll") for (int m = 0; m < 4; ++m) _Pragma("unroll") for (int k = 0; k < 2; ++k) dst[m][k] = *(const PG8_LAS bf16x8*)(lds + PG8_SA(b, h) + aoff + m * 2048 + k * 1024); } while (0)
#define PG8_LDB(dst, b, h) do { _Pragma("unroll") for (int n = 0; n < 2; ++n) _Pragma("unroll") for (int k = 0; k < 2; ++k) dst[n][k] = *(const PG8_LAS bf16x8*)(lds + PG8_SB(b, h) + boff + n * 2048 + k * 1024); } while (0)
#define PG8_MMA(ai, bj, At, Bt) do { __builtin_amdgcn_s_setprio(1); _Pragma("unroll") for (int m = 0; m < 4; ++m) _Pragma("unroll") for (int n = 0; n < 2; ++n) _Pragma("unroll") for (int k = 0; k < 2; ++k) \
        acc[ai][bj][m][n] = __builtin_amdgcn_mfma_f32_16x16x32_bf16(Bt[n][k], At[m][k], acc[ai][bj][m][n], 0, 0, 0); __builtin_amdgcn_s_setprio(0); } while (0)
#define PG8_WAIT_V(n) asm volatile("s_waitcnt vmcnt(" #n ")" ::: "memory")
#define PG8_WAIT_L(n) asm volatile("s_waitcnt lgkmcnt(" #n ")" ::: "memory")
#define PG8_BAR __builtin_amdgcn_s_barrier()
#define PG8_SCHED __builtin_amdgcn_sched_barrier(0)
    Unit cur, nxt; int ui = 0;
    if (!S.next(0, cur)) return;
    f32x4 acc[2][2][4][2];
#pragma unroll
    for (int a = 0; a < 2; ++a)
#pragma unroll
        for (int b = 0; b < 2; ++b)
#pragma unroll
            for (int m = 0; m < 4; ++m)
#pragma unroll
                for (int n = 0; n < 2; ++n) acc[a][b][m][n] = (f32x4){0.f, 0.f, 0.f, 0.f};
    bf16x8 At[4][2], B0[2][2], B1[2][2];
    const char* cA = (const char*)g.A + (size_t)cur.pm * tstep; const char* cB = (const char*)g.Bt + (size_t)cur.pn * tstep;
    S.a_ready(cur);
    if constexpr (SP2) {
        PG8_STAGE(PG8_SB(0, 0), cB, voffB); PG8_STAGE(PG8_SB(0, 1), cB + hstep, voffB); PG8_STAGE(PG8_SA(0, 0), cA, voffA); PG8_STAGE(PG8_SA(0, 1), cA + hstep, voffA);
        if (wr == 1) PG8_BAR;
        PG8_WAIT_V(2); PG8_BAR;
        PG8_STAGE(PG8_SB(1, 0), cB + kstep, voffB); PG8_STAGE(PG8_SA(1, 0), cA + kstep, voffA); PG8_STAGE(PG8_SB(1, 1), cB + hstep + kstep, voffB);
        PG8_WAIT_V(6); PG8_BAR;
    } else {
        PG8_STAGE(PG8_SB(0, 0), cB, voffB); PG8_STAGE(PG8_SA(0, 0), cA, voffA); PG8_STAGE(PG8_SB(0, 1), cB + hstep, voffB); PG8_STAGE(PG8_SA(0, 1), cA + hstep, voffA);
        if (wr == 1) PG8_BAR;
        PG8_WAIT_V(4); PG8_BAR;
        PG8_STAGE(PG8_SB(1, 0), cB + kstep, voffB); PG8_STAGE(PG8_SA(1, 0), cA + kstep, voffA); PG8_STAGE(PG8_SB(1, 1), cB + hstep + kstep, voffB);
        PG8_WAIT_V(6); PG8_BAR;
    }
    for (;;) {
        const bool has_next = S.next(ui + 1, nxt);
        const char* nA = has_next ? (const char*)g.A + (size_t)nxt.pm * tstep : cA; const char* nB = has_next ? (const char*)g.Bt + (size_t)nxt.pn * tstep : cB;
        for (int t = 0; t < nt; t += 2) {
            const bool last = (t == nt - 2);
            const char* a1 = cA + (size_t)(t + 1) * kstep;
            const char* a2 = last ? nA : cA + (size_t)(t + 2) * kstep; const char* b2 = last ? nB : cB + (size_t)(t + 2) * kstep;
            const char* a3 = a2 + kstep; const char* b3 = b2 + kstep;
            if (last && has_next) S.a_ready(nxt);
            if constexpr (SP2) {
            PG8_LDB(B0, 0, 0); PG8_LDB(B1, 0, 1); PG8_SCHED; PG8_LDA(At, 0, 0); PG8_STAGE(PG8_SA(1, 1), a1 + hstep, voffA);
            PG8_WAIT_V(8); PG8_WAIT_L(0); PG8_BAR; PG8_MMA(0, 0, At, B0); PG8_MMA(0, 1, At, B1); PG8_BAR; PG8_SCHED;
            PG8_LDA(At, 0, 1); PG8_STAGE(PG8_SB(0, 0), b2, voffB); PG8_STAGE(PG8_SB(0, 1), b2 + hstep, voffB); PG8_STAGE(PG8_SA(0, 0), a2, voffA);
            PG8_WAIT_V(8); PG8_WAIT_L(0); PG8_BAR; PG8_MMA(1, 0, At, B0); PG8_MMA(1, 1, At, B1); PG8_BAR; PG8_SCHED;
            PG8_LDB(B0, 1, 0); PG8_LDB(B1, 1, 1); PG8_SCHED; PG8_LDA(At, 1, 0); PG8_STAGE(PG8_SA(0, 1), a2 + hstep, voffA);
            PG8_WAIT_V(8); PG8_WAIT_L(0); PG8_BAR; PG8_MMA(0, 0, At, B0); PG8_MMA(0, 1, At, B1); PG8_BAR; PG8_SCHED;
            PG8_LDA(At, 1, 1); PG8_STAGE(PG8_SB(1, 0), b3, voffB); PG8_STAGE(PG8_SB(1, 1), b3 + hstep, voffB); PG8_STAGE(PG8_SA(1, 0), a3, voffA);
            PG8_WAIT_V(8); PG8_WAIT_L(0); PG8_BAR; PG8_MMA(1, 0, At, B0); PG8_MMA(1, 1, At, B1); PG8_BAR; PG8_SCHED;
            } else {
            PG8_LDB(B0, 0, 0); PG8_SCHED; PG8_LDA(At, 0, 0); PG8_STAGE(PG8_SA(1, 1), a1 + hstep, voffA);
            PG8_WAIT_L(8); PG8_BAR; PG8_WAIT_L(0); PG8_MMA(0, 0, At, B0); PG8_BAR; PG8_SCHED;
            PG8_LDB(B1, 0, 1); PG8_STAGE(PG8_SB(0, 0), b2, voffB);
            PG8_BAR; PG8_WAIT_L(0); PG8_MMA(0, 1, At, B1); PG8_BAR;
            PG8_LDA(At, 0, 1); PG8_STAGE(PG8_SA(0, 0), a2, voffA);
            PG8_BAR; PG8_WAIT_L(0); PG8_MMA(1, 0, At, B0); PG8_BAR; PG8_SCHED;
            PG8_STAGE(PG8_SB(0, 1), b2 + hstep, voffB);
            PG8_WAIT_V(6); PG8_BAR; PG8_MMA(1, 1, At, B1); PG8_BAR;
            PG8_LDB(B0, 1, 0); PG8_SCHED; PG8_LDA(At, 1, 0); PG8_STAGE(PG8_SA(0, 1), a2 + hstep, voffA);
            PG8_WAIT_L(8); PG8_BAR; PG8_WAIT_L(0); PG8_MMA(0, 0, At, B0); PG8_BAR; PG8_SCHED;
            PG8_LDB(B1, 1, 1); PG8_STAGE(PG8_SB(1, 0), b3, voffB);
            PG8_BAR; PG8_WAIT_L(0); PG8_MMA(0, 1, At, B1); PG8_BAR;
            PG8_LDA(At, 1, 1); PG8_STAGE(PG8_SA(1, 0), a3, voffA);
            PG8_BAR; PG8_WAIT_L(0); PG8_MMA(1, 0, At, B0); PG8_BAR; PG8_SCHED;
            PG8_STAGE(PG8_SB(1, 1), b3 + hstep, voffB);
            PG8_WAIT_V(6); PG8_BAR; PG8_MMA(1, 1, At, B1); PG8_BAR;
            }
        }
        if constexpr (ALIGN_EPI) { if (wr == 0) PG8_BAR; }
        if constexpr (!Epi::AFTER_DRAIN) { E(acc, cur, wr, wc, fr, fq); S.done(cur); }
        if (!has_next) break;
#pragma unroll
        for (int a = 0; a < 2; ++a)
#pragma unroll
            for (int b = 0; b < 2; ++b)
#pragma unroll
                for (int m = 0; m < 4; ++m)
#pragma unroll
                    for (int n = 0; n < 2; ++n) acc[a][b][m][n] = (f32x4){0.f, 0.f, 0.f, 0.f};
        cur = nxt; cA = nA; cB = nB; ++ui;
        if constexpr (ALIGN_EPI) { if (wr == 1) PG8_BAR; }
    }
    PG8_WAIT_V(0);
    if constexpr (!ALIGN_EPI) { if (wr == 0) PG8_BAR; }
    PG8_BAR;
    if constexpr (Epi::AFTER_DRAIN) { E.fused(acc, cur, wr, wc, fr, fq, lds, wid, lane); S.done(cur); }
#undef PG8_SA
#undef PG8_SB
#undef PG8_STAGE
#undef PG8_LDA
#undef PG8_LDB
#undef PG8_MMA
#undef PG8_WAIT_V
#undef PG8_WAIT_L
#undef PG8_BAR
#undef PG8_SCHED
}
}
namespace attn {
typedef unsigned short bf16;
constexpr int   D = 128, NW = 8, QBLK = 32, KVBLK = 64;
constexpr float SCALE = 0.088388347648318440f;
constexpr float THR = 8.f;
constexpr int LDQ = 1536, LDK = 1536, LDO = 2048;
constexpr size_t SHM_V = KVBLK * D * 2, SHM_K = KVBLK * D * 2, SHM_ATTN = 2 * SHM_V + 2 * SHM_K + NW * 64 * 4;
using bf16x8 = __attribute__((ext_vector_type(8))) short;
using s16x4  = __attribute__((ext_vector_type(4))) short;
using f32x16 = __attribute__((ext_vector_type(16))) float;
using u32x4  = __attribute__((ext_vector_type(4))) unsigned;
#define KSWZ(row, colB) ((row) * 256 + ((colB) ^ (((row) & 7) << 4)))
#define SBAR() __builtin_amdgcn_sched_barrier(0)
__device__ __forceinline__ int crow(int r, int hi) { return (r & 3) + 8 * (r >> 2) + 4 * hi; }
__device__ __forceinline__ unsigned cvtpk(float lo, float hi) {
  unsigned r; asm volatile("v_cvt_pk_bf16_f32 %0, %1, %2" : "=v"(r) : "v"(lo), "v"(hi)); return r;
}
__device__ __forceinline__ bf16x8 ld8(const bf16* p) { return *reinterpret_cast<const bf16x8*>(p); }
__device__ __forceinline__ void expA(f32x16& p0, const float negb) { p0 = p0 + negb; for (int r = 0; r < 16; ++r) p0[r] = __builtin_amdgcn_exp2f(p0[r]); }
__device__ __forceinline__ void finishSM(f32x16& p0, f32x16& p1, const float negb, float& l_reg, bf16x8& pa0, bf16x8& pa1, bf16x8& pa2, bf16x8& pa3) {
  p1 = p1 + negb; for (int r = 0; r < 16; ++r) p1[r] = __builtin_amdgcn_exp2f(p1[r]);
  float ps = 0; for (int r = 0; r < 16; ++r) ps += p0[r]; for (int r = 0; r < 16; ++r) ps += p1[r];
  l_reg += ps;
#define PK4(P, BASE, OUT) do { unsigned a0 = cvtpk(P[BASE + 0], P[BASE + 1]), a1 = cvtpk(P[BASE + 2], P[BASE + 3]);   \
    unsigned b0 = cvtpk(P[BASE + 4], P[BASE + 5]), b1 = cvtpk(P[BASE + 6], P[BASE + 7]);                              \
    auto r0 = __builtin_amdgcn_permlane32_swap(a0, b0, false, false); auto r1 = __builtin_amdgcn_permlane32_swap(a1, b1, false, false); \
    u32x4 w = {r0[0], r1[0], r0[1], r1[1]}; OUT = *reinterpret_cast<bf16x8*>(&w); } while (0)
  PK4(p0, 0, pa0); PK4(p0, 8, pa1); PK4(p1, 0, pa2); PK4(p1, 8, pa3);
#undef PK4
}
__device__ __forceinline__ void qkt(f32x16& p0, f32x16& p1, const bf16* Ks, const bf16x8* qr, int r32, int hi) {
  p0 = f32x16{}; p1 = f32x16{};
  for (int d0 = 0; d0 < 8; ++d0) { int cb = (d0 * 16 + hi * 8) * 2;
    bf16x8 b0 = *reinterpret_cast<const bf16x8*>((const char*)Ks + KSWZ(r32, cb));
    bf16x8 b1 = *reinterpret_cast<const bf16x8*>((const char*)Ks + KSWZ(32 + r32, cb));
    p0 = __builtin_amdgcn_mfma_f32_32x32x16_bf16(b0, qr[d0], p0, 0, 0, 0);
    p1 = __builtin_amdgcn_mfma_f32_32x32x16_bf16(b1, qr[d0], p1, 0, 0, 0); }
}
__device__ __forceinline__ int v_st(int k, int c) { const int kk = (k & ~0xC) | ((k & 4) << 1) | ((k & 8) >> 1); return ((kk >> 3) * 4 + (c >> 5)) * 512 + ((kk & 7) * 32 + (c & 31)) * 2; }
__device__ __forceinline__ int v_rd_base(int lane) { return ((lane & 3) << 3) | (((lane >> 2) & 3) << 6) | (((lane >> 4) & 1) << 5) | (((lane >> 5) & 1) << 8); }
constexpr int v_rd_off(int d0, int ks, int half) { return d0 * 512 + ks * 4096 + half * 2048; }
template <int OFF> __device__ __forceinline__ s16x4 tr_read(int vb) {
  s16x4 r; asm volatile("ds_read_b64_tr_b16 %0, %1 offset:%2" : "=&v"(r) : "v"(vb), "i"(OFF) : "memory"); return r;
}
template <int D0> __device__ __forceinline__ void pv_one(f32x16& od, int vb, bf16x8 pa0, bf16x8 pa1, bf16x8 pa2, bf16x8 pa3) {
  const s16x4 l0 = tr_read<v_rd_off(D0, 0, 0)>(vb), h0 = tr_read<v_rd_off(D0, 0, 1)>(vb), l1 = tr_read<v_rd_off(D0, 1, 0)>(vb), h1 = tr_read<v_rd_off(D0, 1, 1)>(vb);
  const s16x4 l2 = tr_read<v_rd_off(D0, 2, 0)>(vb), h2 = tr_read<v_rd_off(D0, 2, 1)>(vb), l3 = tr_read<v_rd_off(D0, 3, 0)>(vb), h3 = tr_read<v_rd_off(D0, 3, 1)>(vb);
  asm volatile("s_waitcnt lgkmcnt(0)" ::: "memory"); SBAR();
#define PK(L, H) (bf16x8){L[0], L[1], L[2], L[3], H[0], H[1], H[2], H[3]}
  od = __builtin_amdgcn_mfma_f32_32x32x16_bf16(pa0, PK(l0, h0), od, 0, 0, 0);
  od = __builtin_amdgcn_mfma_f32_32x32x16_bf16(pa1, PK(l1, h1), od, 0, 0, 0);
  od = __builtin_amdgcn_mfma_f32_32x32x16_bf16(pa2, PK(l2, h2), od, 0, 0, 0);
  od = __builtin_amdgcn_mfma_f32_32x32x16_bf16(pa3, PK(l3, h3), od, 0, 0, 0);
#undef PK
}
__device__ __forceinline__ void pv_d0(f32x16* o, int vb, bf16x8 pa0, bf16x8 pa1, bf16x8 pa2, bf16x8 pa3) {
  pv_one<0>(o[0], vb, pa0, pa1, pa2, pa3); pv_one<1>(o[1], vb, pa0, pa1, pa2, pa3); pv_one<2>(o[2], vb, pa0, pa1, pa2, pa3); pv_one<3>(o[3], vb, pa0, pa1, pa2, pa3);
}
__device__ __forceinline__ void attn_dense_body(const bf16* __restrict__ Qb, const bf16* __restrict__ Kh, const bf16* __restrict__ Vh,
                                                bf16* __restrict__ Ob, int seq, char* lds, const float negb) {
  const int tid = threadIdx.x, wid = tid >> 6, lane = tid & 63, r32 = lane & 31, hi = lane >> 5;
  bf16* V_lds = (bf16*)lds; bf16* K_lds = (bf16*)(lds + 2 * SHM_V);
  float* ws = (float*)(lds + 2 * SHM_V + 2 * SHM_K) + wid * 64; float* li_l = ws;
  float l_reg = 0; f32x16 o[4] = {}; bf16x8 qr[8];
  const bf16* Qw = Qb + (long)(wid * QBLK + r32) * LDQ + hi * 8;
#pragma unroll
  for (int d0 = 0; d0 < 8; ++d0) qr[d0] = ld8(Qw + d0 * 16);
  const int sr = tid >> 4, sc = (tid & 15) * 8, vst0 = v_st(sr, sc), vst1 = v_st(32 + sr, sc);
  const int vb0 = (int)(uintptr_t)V_lds + v_rd_base(lane);
  struct { bf16x8 vs0, vs1, ks0, ks1; } sr_[1];
  const unsigned so0 = (unsigned)(sr * LDK + sc);
#define SLOAD(i, k0) do { const unsigned a_ = (unsigned)(k0) * (unsigned)LDK + so0; sr_[i].vs0 = ld8(Kh + (a_ + 256u)); sr_[i].vs1 = ld8(Kh + (a_ + 32u * LDK + 256u)); \
    sr_[i].ks0 = ld8(Kh + a_); sr_[i].ks1 = ld8(Kh + (a_ + 32u * LDK)); } while (0)
#define SWRITE(b, i) do { *(bf16x8*)((char*)V_lds + (b) * SHM_V + vst0) = sr_[i].vs0;          \
    *(bf16x8*)((char*)V_lds + (b) * SHM_V + vst1) = sr_[i].vs1; int kc = sc * 2;               \
    *(bf16x8*)((char*)K_lds + (b) * SHM_K + KSWZ(sr, kc)) = sr_[i].ks0;                       \
    *(bf16x8*)((char*)K_lds + (b) * SHM_K + KSWZ(32 + sr, kc)) = sr_[i].ks1; } while (0)
#define SWAIT() asm volatile("s_waitcnt vmcnt(0)" ::: "memory")
  f32x16 pA0, pA1, pB0, pB1; bf16x8 pa0, pa1, pa2, pa3; const int NT = seq / KVBLK;
  constexpr int SE = 0, SO = 0;
  SLOAD(SE, 0); asm volatile("s_waitcnt vmcnt(0)" ::: "memory"); SWRITE(0, SE); __syncthreads();
  qkt(pA0, pA1, K_lds, qr, r32, hi); expA(pA0, negb);
  SLOAD(SO, KVBLK);
  SWAIT(); SWRITE(1, SO); __syncthreads();
  for (int j = 1; j + 1 < NT; j += 2) {
    SBAR(); qkt(pB0, pB1, (bf16*)((char*)K_lds + SHM_K), qr, r32, hi);
    finishSM(pA0, pA1, negb, l_reg, pa0, pa1, pa2, pa3); SBAR();
    SLOAD(SO, (j + 1) * KVBLK); SBAR();
    pv_d0(o, vb0, pa0, pa1, pa2, pa3); SBAR(); expA(pB0, negb); SBAR();
    __syncthreads(); SWAIT(); SWRITE(0, SE); SBAR();
    __syncthreads();
    SBAR(); qkt(pA0, pA1, K_lds, qr, r32, hi);
    finishSM(pB0, pB1, negb, l_reg, pa0, pa1, pa2, pa3); SBAR();
    SLOAD(SE, (j + 2) * KVBLK); SBAR();
    pv_d0(o, vb0 + (int)SHM_V, pa0, pa1, pa2, pa3); SBAR(); expA(pA0, negb); SBAR();
    __syncthreads(); SWAIT(); SWRITE(1, SO); SBAR();
    __syncthreads();
  }
  SBAR(); qkt(pB0, pB1, (bf16*)((char*)K_lds + SHM_K), qr, r32, hi);
  finishSM(pA0, pA1, negb, l_reg, pa0, pa1, pa2, pa3); SBAR();
  pv_d0(o, vb0, pa0, pa1, pa2, pa3); expA(pB0, negb);
  __syncthreads();
  finishSM(pB0, pB1, negb, l_reg, pa0, pa1, pa2, pa3); SBAR();
  pv_d0(o, vb0 + (int)SHM_V, pa0, pa1, pa2, pa3);
  { auto rr = __builtin_amdgcn_permlane32_swap(__float_as_uint(l_reg), __float_as_uint(l_reg), false, false); l_reg = __uint_as_float(rr[0]) + __uint_as_float(rr[1]); }
  if (hi == 0) li_l[r32] = l_reg; asm volatile("s_waitcnt lgkmcnt(0)" ::: "memory");
  float rli[16];
#pragma unroll
  for (int r = 0; r < 16; ++r) rli[r] = __builtin_amdgcn_rcpf(li_l[crow(r, hi)]);
  bf16* Ow = Ob + (long)(wid * QBLK) * LDO;
#pragma unroll
  for (int r = 0; r < 16; ++r) { int orow = crow(r, hi);
#pragma unroll
    for (int d0 = 0; d0 < 4; d0 += 2) { const unsigned pk = cvtpk(o[d0][r] * rli[r], o[d0 + 1][r] * rli[r]);
      Ow[(long)orow * LDO + d0 * 32 + r32] = (bf16)(pk & 0xffffu); Ow[(long)orow * LDO + (d0 + 1) * 32 + r32] = (bf16)(pk >> 16); } }
  __syncthreads();
#undef SLOAD
#undef SWRITE
#undef SWAIT
}
#undef KSWZ
#undef SBAR
}
#define LAS __attribute__((address_space(3)))
typedef unsigned short bf16_t;
typedef float f32x4 __attribute__((ext_vector_type(4)));
typedef unsigned u32x4v __attribute__((ext_vector_type(4)));
typedef unsigned u32x2v __attribute__((ext_vector_type(2)));
constexpr int NTHR = 512, NWAVES = 8;
constexpr int M_P = 8192, M_S = 32768, M_ALL = 40960, L_P = 4096, L_S = 8192;
constexpr int DM = 2048, DFF = 5632, NIN = 4608, NQKV = 1536, NHY = 3072, DH = 1024;
constexpr float EPS = 1e-6f;
constexpr size_t MiB = 1u << 20;
constexpr size_t WS_W13A = 2 * MiB, WS_W2A = 46 * MiB, WS_WIN = 68 * MiB, WS_WOUT = 86 * MiB, WS_W13B = 94 * MiB, WS_W2B = 138 * MiB;
constexpr size_t WS_XN = 160 * MiB, WS_ACT = 320 * MiB;
constexpr size_t WS_QKV = WS_ACT, WS_HYT = WS_ACT + 120 * MiB, WS_HYO = WS_ACT + 360 * MiB;
constexpr size_t WS_H2S = 760 * MiB, WS_H2P = 762 * MiB, WS_KSP = 764 * MiB, WS_FTS = 844 * MiB, WS_H2B = 972 * MiB, WS_W3T = 978 * MiB, WS_XN2 = 844 * MiB, WS_END = 1004 * MiB;
constexpr size_t WS_PCNT = 65536, WS_PART = 262144;
constexpr size_t WS_FTP = 2 * MiB;
constexpr int FFT_XBYTES = (16384 + 16384 / 16) * 8;
constexpr int LDS_COEF = FFT_XBYTES, LDS_RED = LDS_COEF + 1024, LDS_BYTES = 147456;
static_assert(LDS_RED + 256 <= LDS_BYTES, "lds map");

struct Args {
    const float* in[25]; float* out; unsigned char* ws; int ph_lo, ph_hi;
};

__device__ __forceinline__ float bf2f(bf16_t v) { return __uint_as_float((unsigned)v << 16); }
__device__ __forceinline__ unsigned f2bf(float f) { unsigned u = __float_as_uint(f); return (u + 0x7fffu + ((u >> 16) & 1u)) >> 16; }
__device__ __forceinline__ unsigned pk2(float lo, float hi) { return f2bf(lo) | (f2bf(hi) << 16); }
__device__ __forceinline__ float wave_sum(float v) {
#pragma unroll
    for (int o = 1; o < 64; o <<= 1) v += __shfl_xor(v, o);
    return v;
}
__device__ __forceinline__ float sin2pi(float turns) { return __builtin_amdgcn_sinf(turns); }
__device__ __forceinline__ float cos2pi(float turns) { return __builtin_amdgcn_cosf(turns); }
#define LDS_WAIT() asm volatile("s_waitcnt lgkmcnt(0)" ::: "memory")

__device__ __forceinline__ void transpose_item(const float* W, int K, int N, bf16_t* WT, int k0, int n0, int drow0, LAS float* scr, int lane, int dstride = 1) {
#pragma unroll 8
    for (int i = 0; i < 32; ++i) { const int kk = 2 * i + (lane >> 5); scr[kk * 33 + (lane & 31)] = __builtin_nontemporal_load(W + (size_t)(k0 + kk) * N + n0 + (lane & 31)); }
    LDS_WAIT(); asm volatile("" ::: "memory");
    const int c = lane & 7;
#pragma unroll
    for (int j = 0; j < 4; ++j) { const int n = (lane >> 3) + 8 * j; const LAS float* s = scr + (8 * c) * 33 + n;
        u32x4v o; o.x = pk2(s[0 * 33], s[1 * 33]); o.y = pk2(s[2 * 33], s[3 * 33]); o.z = pk2(s[4 * 33], s[5 * 33]); o.w = pk2(s[6 * 33], s[7 * 33]);
        *(u32x4v*)(WT + (size_t)(drow0 + dstride * n) * K + k0 + 8 * c) = o; }
    LDS_WAIT(); asm volatile("" ::: "memory");
}
__device__ __forceinline__ int swiglu_row(int n0) { return n0 < DFF ? (n0 / 128) * 256 + (n0 % 128) : ((n0 - DFF) / 128) * 256 + 128 + ((n0 - DFF) % 128); }

__device__ __forceinline__ void rms_row_bf16(const float* xrow, const float* g, bf16_t* orow, int lane) {
    const f32x4* xr = (const f32x4*)xrow + lane; const f32x4* gr = (const f32x4*)g + lane;
    f32x4 v[8]; float s = 0.f;
#pragma unroll
    for (int j = 0; j < 8; ++j) { v[j] = __builtin_nontemporal_load(xr + 64 * j);        s += (v[j].x * v[j].x + v[j].y * v[j].y) + (v[j].z * v[j].z + v[j].w * v[j].w); }
    const float rstd = 1.0f / sqrtf(wave_sum(s) * (1.f / DM) + EPS);
    unsigned long long* o8 = (unsigned long long*)orow + lane;
#pragma unroll
    for (int j = 0; j < 8; ++j) { const f32x4 gg = gr[64 * j];
        o8[64 * j] = (unsigned long long)pk2(v[j].x * rstd * gg.x, v[j].y * rstd * gg.y) | ((unsigned long long)pk2(v[j].z * rstd * gg.z, v[j].w * rstd * gg.w) << 32); }
}
__device__ __forceinline__ void rms_row_f32(float* xrow, const float* g, int lane) {
    f32x4* xr = (f32x4*)xrow + lane; const f32x4* gr = (const f32x4*)g + lane;
    f32x4 v[8]; float s = 0.f;
#pragma unroll
    for (int j = 0; j < 8; ++j) { v[j] = xr[64 * j]; s += (v[j].x * v[j].x + v[j].y * v[j].y) + (v[j].z * v[j].z + v[j].w * v[j].w); }
    const float rstd = 1.0f / sqrtf(wave_sum(s) * (1.f / DM) + EPS);
#pragma unroll
    for (int j = 0; j < 8; ++j) { const f32x4 gg = gr[64 * j]; xr[64 * j] = v[j] * rstd * gg; }
}

__device__ __forceinline__ void h2_row(int L, int t, bf16_t* H2Brow, const float* w1, const float* b1, const float* w2, const float* b2, const float* fq, int lane) {
    float feat = 0.f;
    if (lane == 0) feat = (float)t / (float)(L - 1);
    else if (lane <= 32) { const int j = (lane - 1) & 15; const float fr = 1e-4f + (float)j * ((15.0f - 1e-4f) / 15.0f); const float turns = fr * (float)t / (float)L;
        feat = (lane <= 16) ? cos2pi(turns) : -sin2pi(turns); }
    const float fql = fq[lane];
    float a = b1[lane];
    for (int i = 0; i < 33; ++i) a += __shfl(feat, i) * w1[i * 64 + lane];
    const float h1 = sin2pi(fql * a * 0.15915494309189535f);
    float b = b2[lane];
    for (int k = 0; k < 64; ++k) b += __shfl(h1, k) * w2[k * 64 + lane];
    H2Brow[lane] = (bf16_t)f2bf(sin2pi(fql * b * 0.15915494309189535f));
    H2Brow[64 + lane] = 0; H2Brow[128 + lane] = 0; H2Brow[192 + lane] = 0;
}

__device__ __forceinline__ void qk_row(bf16_t* row, int t, const float* qn, const float* kn, int lane) {
    const int i = lane & 31, half = lane >> 5; const int e0 = half * 64 + i, e1 = e0 + 32;
    const float inv = __builtin_amdgcn_exp2f(-(float)i * (13.287712379549449f / 32.0f));
    const float pos = half ? (float)(t & 63) : (float)(t >> 6);
    const float turns = pos * inv * 0.15915494309189535f; const float c = cos2pi(turns), s = sin2pi(turns);
    const float gq0 = qn[e0], gq1 = qn[e1], gk0 = kn[e0], gk1 = kn[e1];
#pragma unroll
    for (int hh = 0; hh < 10; ++hh) { bf16_t* p = row + hh * 128;
        float x0 = bf2f(p[e0]), x1 = bf2f(p[e1]);
        const float rstd = 1.0f / sqrtf(wave_sum(x0 * x0 + x1 * x1) * (1.f / 128.f) + EPS);
        x0 *= rstd * (hh < 8 ? gq0 : gk0); x1 *= rstd * (hh < 8 ? gq1 : gk1);
        const float qs = hh < 8 ? 0.12751743082459868f : 1.0f;
        p[e0] = (bf16_t)f2bf((x0 * c - x1 * s) * qs); p[e1] = (bf16_t)f2bf((x1 * c + x0 * s) * qs); }
}
typedef float cf __attribute__((ext_vector_type(2)));
__device__ __forceinline__ cf cmul(cf a, cf b) {
    cf d;
    asm("v_pk_mul_f32 %0, %1, %2 op_sel:[0,0] op_sel_hi:[0,1]" : "=v"(d) : "v"(a), "v"(b));
    asm("v_pk_fma_f32 %0, %1, %2, %0 op_sel:[1,1,0] op_sel_hi:[1,0,1] neg_lo:[0,1,0]" : "+v"(d) : "v"(a), "v"(b));
    return d;
}
__device__ __forceinline__ cf twid(float turns, bool inv) {
    const float c = cos2pi(turns), s = sin2pi(turns);
    cf w = inv ? cf{c, s} : cf{c, -s};
    asm volatile("s_nop 1" : "+v"(w));
    return w;
}
__device__ __forceinline__ int fphys(int i) { return i + ((i >> 5) << 1); }
typedef float f32x2v __attribute__((ext_vector_type(2)));
__device__ __forceinline__ cf xld(const LAS cf* X, int i) { const f32x2v v = *(const LAS f32x2v*)(X + fphys(i)); return {v.x, v.y}; }
__device__ __forceinline__ void xst(LAS cf* X, int i, cf v) { *(LAS f32x2v*)(X + fphys(i)) = (f32x2v){v.x, v.y}; }
template <bool INV> __device__ __forceinline__ void bfly4(cf& a0, cf& a1, cf& a2, cf& a3) {
    const cf t0 = a0 + a2, t1 = a0 - a2, t2 = a1 + a3, t3 = a1 - a3;
    const cf mi3 = INV ? cf{-t3.y, t3.x} : cf{t3.y, -t3.x};
    a0 = t0 + t2; a2 = t0 - t2; a1 = t1 + mi3; a3 = t1 - mi3;
}
template <bool INV> __device__ __forceinline__ cf w16c(float c, float s) { return INV ? cf{c, -s} : cf{c, s}; }
template <bool INV> __device__ __forceinline__ void dft16(cf (&a)[16]) {
#pragma unroll
    for (int n0 = 0; n0 < 4; ++n0) bfly4<INV>(a[n0], a[n0 + 4], a[n0 + 8], a[n0 + 12]);
    const float C1 = 0.92387953251128674f, S1 = 0.38268343236508977f, R2 = 0.70710678118654752f;
    a[1 + 4]  = cmul(a[1 + 4],  w16c<INV>(C1, -S1));
    a[1 + 8]  = cmul(a[1 + 8],  w16c<INV>(R2, -R2));
    a[1 + 12] = cmul(a[1 + 12], w16c<INV>(S1, -C1));
    a[2 + 4]  = cmul(a[2 + 4],  w16c<INV>(R2, -R2));
    a[2 + 8]  = cmul(a[2 + 8],  w16c<INV>(0.f, -1.f));
    a[2 + 12] = cmul(a[2 + 12], w16c<INV>(-R2, -R2));
    a[3 + 4]  = cmul(a[3 + 4],  w16c<INV>(S1, -C1));
    a[3 + 8]  = cmul(a[3 + 8],  w16c<INV>(-R2, -R2));
    a[3 + 12] = cmul(a[3 + 12], w16c<INV>(-C1, S1));
#pragma unroll
    for (int k0 = 0; k0 < 4; ++k0) bfly4<INV>(a[4 * k0], a[4 * k0 + 1], a[4 * k0 + 2], a[4 * k0 + 3]);
}
#define O16(k) (4 * ((k) & 3) + ((k) >> 2))
template <int S, bool INV> __device__ __forceinline__ void stage16(LAS cf* X, const int N) {
    constexpr int q = S / 16; const int G = N >> 4;
    static_assert(q == 16 || q % 32 == 0, "stage16: q is 16 or a multiple of 32");
    int tid_ = threadIdx.x; asm volatile("" : "+v"(tid_));
#pragma unroll 1
    for (int g = tid_; g < G; g += NTHR) {
        const int blk = g / q, j = g % q;
        LAS f32x2v* pb = (LAS f32x2v*)X + (fphys(blk * S) + (q == 16 ? j : fphys(j)));
#define POFF(i) (q == 16 ? (16 * (i) + 2 * ((i) >> 1)) : (i) * (q + 2 * (q / 32)))
        cf a[16];
#pragma unroll
        for (int i = 0; i < 16; ++i) { const f32x2v v = pb[POFF(i)]; a[i] = cf{v.x, v.y}; }
        cf w[16];
        {
            w[1] = twid((float)j * (1.0f / (float)S), INV);
            w[2] = cmul(w[1], w[1]); w[3] = cmul(w[2], w[1]); w[4] = cmul(w[2], w[2]); w[5] = cmul(w[4], w[1]); w[6] = cmul(w[3], w[3]); w[7] = cmul(w[4], w[3]); w[8] = cmul(w[4], w[4]);
#pragma unroll
            for (int k = 9; k < 16; ++k) w[k] = cmul(w[8], w[k - 8]);
        }
        if constexpr (INV) {
#pragma unroll
            for (int k = 1; k < 16; ++k) a[k] = cmul(a[k], w[k]);
            dft16<true>(a);
#pragma unroll
            for (int n = 0; n < 16; ++n) pb[POFF(n)] = (f32x2v){a[O16(n)].x, a[O16(n)].y};
        } else {
            dft16<false>(a);
#pragma unroll
            for (int k = 0; k < 16; ++k) { cf o = a[O16(k)]; if (k > 0) o = cmul(o, w[k]); pb[POFF(k)] = (f32x2v){o.x, o.y}; }
        }
#undef POFF
    }
}
template <int R0, bool INV> __device__ __forceinline__ void stage_r0(LAS cf* X, const int N) {
    const int q = N / R0;
    int tid_ = threadIdx.x; asm volatile("" : "+v"(tid_));
#pragma unroll 1
    for (int j = tid_; j < q; j += NTHR) {
        const cf w1 = twid((float)j / (float)N, INV);
        if constexpr (R0 == 4) {
            cf a0 = xld(X, j), a1 = xld(X, j + q), a2 = xld(X, j + 2 * q), a3 = xld(X, j + 3 * q);
            const cf w2 = cmul(w1, w1), w3 = cmul(w2, w1);
            if constexpr (INV) { a1 = cmul(a1, w1); a2 = cmul(a2, w2); a3 = cmul(a3, w3); bfly4<true>(a0, a1, a2, a3); }
            else { bfly4<false>(a0, a1, a2, a3); a1 = cmul(a1, w1); a2 = cmul(a2, w2); a3 = cmul(a3, w3); }
            xst(X, j, a0); xst(X, j + q, a1); xst(X, j + 2 * q, a2); xst(X, j + 3 * q, a3);
        } else {
            cf a0 = xld(X, j), a1 = xld(X, j + q);
            if constexpr (INV) { a1 = cmul(a1, w1); xst(X, j, a0 + a1); xst(X, j + q, a0 - a1); }
            else { xst(X, j, a0 + a1); xst(X, j + q, cmul(a0 - a1, w1)); }
        }
    }
}
__device__ __forceinline__ void stage16_last_store(const LAS cf* X, const int N, f32x4* Kst) {
    const int G = N >> 4;
    int tid_ = threadIdx.x; asm volatile("" : "+v"(tid_));
#pragma unroll 1
    for (int g = tid_; g < G; g += NTHR) {
        const LAS f32x4* xp = (const LAS f32x4*)(X + fphys(16 * g));
        cf a[16];
#pragma unroll
        for (int i = 0; i < 8; ++i) { const f32x4 v = xp[i]; a[2 * i] = cf{v.x, v.y}; a[2 * i + 1] = cf{v.z, v.w}; }
        dft16<false>(a);
#pragma unroll
        for (int i = 0; i < 8; ++i) Kst[(unsigned)(i * G + g)] = (f32x4){a[2 * i].x, a[2 * i].y, a[2 * i + 1].x, a[2 * i + 1].y};
    }
}
__device__ __forceinline__ void stage16_last_inplace(LAS cf* X, const int N) {
    const int G = N >> 4;
    int tid_ = threadIdx.x; asm volatile("" : "+v"(tid_));
#pragma unroll 1
    for (int g = tid_; g < G; g += NTHR) {
        LAS f32x4* xp = (LAS f32x4*)(X + fphys(16 * g));
        cf a[16];
#pragma unroll
        for (int i = 0; i < 8; ++i) { const f32x4 v = xp[i]; a[2 * i] = cf{v.x, v.y}; a[2 * i + 1] = cf{v.z, v.w}; }
        dft16<false>(a);
#pragma unroll
        for (int i = 0; i < 8; ++i) { const cf u = a[O16(2 * i)], v = a[O16(2 * i + 1)]; xp[i] = (f32x4){u.x, u.y, v.x, v.y}; }
    }
}
__device__ __forceinline__ void split_store(const LAS cf* X, const int N, f32x4* K0st, f32x4* K1st) {
    const int G = N >> 4, R = G;
    const int sh = (N == 16384) ? 2 : 1;
    int tid_ = threadIdx.x; asm volatile("" : "+v"(tid_));
#pragma unroll 1
    for (int g = tid_; g < G; g += NTHR) {
        const int ka = g >> 8, kb = (g >> 4) & 15, kc = g & 15;
        const int rho = ka + ((kb + 16 * kc) << sh);
        const int rp = (R - rho) & (R - 1);
        const int ka2 = rp & ((1 << sh) - 1), rest = rp >> sh, kb2 = rest & 15, kc2 = rest >> 4;
        const int g2 = (ka2 << 8) + (kb2 << 4) + kc2;
        const LAS f32x4* xa = (const LAS f32x4*)(X + fphys(16 * g)); const LAS f32x4* xb = (const LAS f32x4*)(X + fphys(16 * g2));
        cf f[16], p[16];
#pragma unroll
        for (int i = 0; i < 8; ++i) { const f32x4 v = xa[i]; f[2 * i] = cf{v.x, v.y}; f[2 * i + 1] = cf{v.z, v.w}; const f32x4 w = xb[i]; p[2 * i] = cf{w.x, w.y}; p[2 * i + 1] = cf{w.z, w.w}; }
        cf k0[16], k1[16];
        const bool z = (rho == 0);
#pragma unroll
        for (int k = 0; k < 16; ++k) { const cf pa = p[15 - k], pb = p[(16 - k) & 15]; const cf pp = z ? pb : pa;
            const cf s = cf{f[k].x + pp.x, f[k].y - pp.y}, d = cf{f[k].x - pp.x, f[k].y + pp.y};
            k0[k] = cf{0.5f * s.x, 0.5f * s.y}; k1[k] = cf{0.5f * d.y, -0.5f * d.x}; }
#pragma unroll
        for (int i = 0; i < 8; ++i) { const cf u0 = k0[O16(2 * i)], v0 = k0[O16(2 * i + 1)], u1 = k1[O16(2 * i)], v1 = k1[O16(2 * i + 1)];
            K0st[(unsigned)(i * G + g)] = (f32x4){u0.x, u0.y, v0.x, v0.y}; K1st[(unsigned)(i * G + g)] = (f32x4){u1.x, u1.y, v1.x, v1.y}; }
    }
}
__device__ __forceinline__ void stage16_mid(LAS cf* X, const int N, const f32x4* Kst, const float sc) {
    const int G = N >> 4;
    int tid_ = threadIdx.x; asm volatile("" : "+v"(tid_));
#pragma unroll 1
    for (int g = tid_; g < G; g += NTHR) {
        LAS f32x4* xp = (LAS f32x4*)(X + fphys(16 * g));
        f32x4 kk[8];
#pragma unroll
        for (int i = 0; i < 8; ++i) kk[i] = Kst[(unsigned)(i * G + g)];
        cf a[16];
#pragma unroll
        for (int i = 0; i < 8; ++i) { const f32x4 v = xp[i]; a[2 * i] = cf{v.x, v.y}; a[2 * i + 1] = cf{v.z, v.w}; }
        dft16<false>(a);
#pragma unroll
        for (int i = 0; i < 8; ++i) { cf p0 = cmul(a[2 * i], cf{kk[i].x, kk[i].y}), p1 = cmul(a[2 * i + 1], cf{kk[i].z, kk[i].w}); a[2 * i] = cf{p0.x * sc, p0.y * sc}; a[2 * i + 1] = cf{p1.x * sc, p1.y * sc}; }
        cf b[16];
#pragma unroll
        for (int k = 0; k < 16; ++k) b[k] = a[O16(k)];
        dft16<true>(b);
#pragma unroll
        for (int i = 0; i < 8; ++i) { const cf u = b[O16(2 * i)], v = b[O16(2 * i + 1)]; xp[i] = (f32x4){u.x, u.y, v.x, v.y}; }
    }
}
__device__ __forceinline__ void fft_fwd_head(LAS cf* X, const int N) {
    if (N == 16384) stage_r0<4, false>(X, N); else stage_r0<2, false>(X, N);
    __syncthreads();
    stage16<4096, false>(X, N); __syncthreads();
    stage16<256, false>(X, N); __syncthreads();
}
__device__ __forceinline__ void fft_inv_tail(LAS cf* X, const int N) {
    stage16<256, true>(X, N); __syncthreads();
    stage16<4096, true>(X, N); __syncthreads();
    if (N == 16384) stage_r0<4, true>(X, N); else stage_r0<2, true>(X, N);
    __syncthreads();
}

#define VEL(v, e) ((v)[(e) >> 2][(e) & 3])
template <int R0> __device__ __forceinline__ void r0_fwd_store(LAS cf* X, const int N, int j0, const f32x4 (&ar)[R0 / 2][2], const f32x4 (&ai)[R0 / 2][2]) {
    constexpr int q = 4096; const float rN = 1.0f / (float)N; asm volatile("" : "+v"(j0));
#pragma unroll
    for (int e = 0; e < 8; e += 2) {
        cf y[R0][2];
#pragma unroll
        for (int h = 0; h < 2; ++h) { const int j = j0 + e + h; const cf w1 = twid((float)j * rN, false);
            if constexpr (R0 == 4) { const cf a0 = cf{VEL(ar[0], e + h), VEL(ai[0], e + h)}, a1 = cf{VEL(ar[1], e + h), VEL(ai[1], e + h)}; const cf m = cf{a1.y, -a1.x};
                const cf w2 = cmul(w1, w1), w3 = cmul(w2, w1);
                y[0][h] = a0 + a1; y[1][h] = cmul(a0 + m, w1); y[2][h] = cmul(a0 - a1, w2); y[3][h] = cmul(a0 - m, w3); }
            else { const cf a0 = cf{VEL(ar[0], e + h), VEL(ai[0], e + h)}; y[0][h] = a0; y[1][h] = cmul(a0, w1); } }
#pragma unroll
        for (int k = 0; k < R0; ++k) *(LAS f32x4*)(X + fphys(j0 + e + k * q)) = (f32x4){y[k][0].x, y[k][0].y, y[k][1].x, y[k][1].y};
    }
}
template <int R0> __device__ __forceinline__ void r0_inv_load(const LAS cf* X, const int N, int j0, f32x4 (&yr)[R0 / 2][2], f32x4 (&yi)[R0 / 2][2]) {
    constexpr int q = 4096; const float rN = 1.0f / (float)N; asm volatile("" : "+v"(j0));
#pragma unroll
    for (int e = 0; e < 8; e += 2) {
        f32x4 v[R0];
#pragma unroll
        for (int k = 0; k < R0; ++k) v[k] = *(const LAS f32x4*)(X + fphys(j0 + e + k * q));
#pragma unroll
        for (int h = 0; h < 2; ++h) { const int j = j0 + e + h; const cf w1 = twid((float)j * rN, true);
            if constexpr (R0 == 4) { const cf w2 = cmul(w1, w1), w3 = cmul(w2, w1);
                const cf a0 = h ? cf{v[0].z, v[0].w} : cf{v[0].x, v[0].y}; const cf a1 = cmul(h ? cf{v[1].z, v[1].w} : cf{v[1].x, v[1].y}, w1);
                const cf a2 = cmul(h ? cf{v[2].z, v[2].w} : cf{v[2].x, v[2].y}, w2); const cf a3 = cmul(h ? cf{v[3].z, v[3].w} : cf{v[3].x, v[3].y}, w3);
                const cf t0 = a0 + a2, t1 = a0 - a2, t2 = a1 + a3, t3 = a1 - a3;
                VEL(yr[0], e + h) = t0.x + t2.x; VEL(yi[0], e + h) = t0.y + t2.y; VEL(yr[1], e + h) = t1.x - t3.y; VEL(yi[1], e + h) = t1.y + t3.x; }
            else { const cf a0 = h ? cf{v[0].z, v[0].w} : cf{v[0].x, v[0].y}; const cf a1 = cmul(h ? cf{v[1].z, v[1].w} : cf{v[1].x, v[1].y}, w1);
                VEL(yr[0], e + h) = a0.x + a1.x; VEL(yi[0], e + h) = a0.y + a1.y; } }
    }
}
__device__ __forceinline__ void fft_mid_chain(LAS cf* X, const int N, const f32x4* Kst, const float sc) {
    __syncthreads();
    stage16<4096, false>(X, N); __syncthreads();
    stage16<256, false>(X, N); __syncthreads();
    stage16_mid(X, N, Kst, sc); __syncthreads();
    stage16<256, true>(X, N); __syncthreads();
    stage16<4096, true>(X, N); __syncthreads();
}
struct HyParams { const float *conv_w, *conv_b, *w3, *decay, *hbias; const bf16_t* hyT; bf16_t* hyo; };
__device__ __forceinline__ void conv8(const bf16_t* hyT, unsigned off, int t0, int L, float w0, float w1, float w2, float b, f32x4 (&o)[2]) {
    const u32x4v raw = *(const u32x4v*)(hyT + (off + (unsigned)t0));
    const float xm = t0 > 0 ? bf2f(hyT[off + (unsigned)t0 - 1u]) : 0.f, xp = t0 + 8 < L ? bf2f(hyT[off + (unsigned)t0 + 8u]) : 0.f;
    const float x0 = __uint_as_float(raw.x << 16), x1 = __uint_as_float(raw.x & 0xffff0000u), x2 = __uint_as_float(raw.y << 16), x3 = __uint_as_float(raw.y & 0xffff0000u);
    const float x4 = __uint_as_float(raw.z << 16), x5 = __uint_as_float(raw.z & 0xffff0000u), x6 = __uint_as_float(raw.w << 16), x7 = __uint_as_float(raw.w & 0xffff0000u);
    o[0][0] = fmaf(xm, w0, fmaf(x0, w1, fmaf(x1, w2, b))); o[0][1] = fmaf(x0, w0, fmaf(x1, w1, fmaf(x2, w2, b))); o[0][2] = fmaf(x1, w0, fmaf(x2, w1, fmaf(x3, w2, b))); o[0][3] = fmaf(x2, w0, fmaf(x3, w1, fmaf(x4, w2, b)));
    o[1][0] = fmaf(x3, w0, fmaf(x4, w1, fmaf(x5, w2, b))); o[1][1] = fmaf(x4, w0, fmaf(x5, w1, fmaf(x6, w2, b))); o[1][2] = fmaf(x5, w0, fmaf(x6, w1, fmaf(x7, w2, b))); o[1][3] = fmaf(x6, w0, fmaf(x7, w1, fmaf(xp, w2, b)));
}
__device__ __forceinline__ float block_sum(float v, LAS float* red) {
    v = wave_sum(v);
    __syncthreads();
    if ((threadIdx.x & 63) == 0) red[threadIdx.x >> 6] = v;
    __syncthreads();
    float s = 0.f;
#pragma unroll
    for (int i = 0; i < NWAVES; ++i) s += red[i];
    return s;
}
template <int R0> __device__ __forceinline__ void hy_pair(LAS cf* X, const int N, const int L, const int tid, const unsigned mA, const unsigned mB, const bf16_t* hyT, bf16_t* hyo,
        const unsigned ov, const unsigned oa, const unsigned ob, const f32x4* K0, const f32x4* K1, f32x4* ZS, const float sc0, const float sc1, const float d0, const float d1,
        const float wv0, const float wv1, const float wv2, const float bv, const float wa0, const float wa1, const float wa2, const float ba,
        const float wb0, const float wb1, const float wb2, const float bb) {
    constexpr int NL = R0 / 2; int j0 = 8 * tid; asm volatile("" : "+v"(j0));
    {   f32x4 vr[NL][2], vi[NL][2];
#pragma unroll
        for (int n = 0; n < NL; ++n) { conv8(hyT, ov + mA, j0 + n * 4096, L, wv0, wv1, wv2, bv, vr[n]); conv8(hyT, ov + mB, j0 + n * 4096, L, wv0, wv1, wv2, bv, vi[n]); }
        r0_fwd_store<R0>(X, N, j0, vr, vi); }
    fft_mid_chain(X, N, K0, sc0);
    {   f32x4 yr[NL][2], yi[NL][2]; r0_inv_load<R0>(X, N, j0, yr, yi);
#pragma unroll
        for (int n = 0; n < NL; ++n) { const int t0 = j0 + n * 4096; f32x4 va[2], vb[2], xa[2], xb[2];
            conv8(hyT, ov + mA, t0, L, wv0, wv1, wv2, bv, va); conv8(hyT, ov + mB, t0, L, wv0, wv1, wv2, bv, vb);
            conv8(hyT, oa + mA, t0, L, wa0, wa1, wa2, ba, xa); conv8(hyT, oa + mB, t0, L, wa0, wa1, wa2, ba, xb);
#pragma unroll
            for (int q4 = 0; q4 < 2; ++q4) { yr[n][q4] = xa[q4] * (yr[n][q4] + va[q4] * d0); yi[n][q4] = xb[q4] * (yi[n][q4] + vb[q4] * d0); }
#pragma unroll
            for (int e = 0; e < 8; e += 2) ZS[(unsigned)((t0 + e) >> 1)] = (f32x4){VEL(yr[n], e), VEL(yi[n], e), VEL(yr[n], e + 1), VEL(yi[n], e + 1)}; }
        r0_fwd_store<R0>(X, N, j0, yr, yi); }
    fft_mid_chain(X, N, K1, sc1);
    {   f32x4 yr[NL][2], yi[NL][2]; r0_inv_load<R0>(X, N, j0, yr, yi);
#pragma unroll
        for (int n = 0; n < NL; ++n) { const int t0 = j0 + n * 4096; f32x4 xa[2], xb[2];
            conv8(hyT, ob + mA, t0, L, wb0, wb1, wb2, bb, xa); conv8(hyT, ob + mB, t0, L, wb0, wb1, wb2, bb, xb);
            u32x4v oA, oB;
#pragma unroll
            for (int e = 0; e < 8; e += 2) { const f32x4 z = ZS[(unsigned)((t0 + e) >> 1)];
                oA[e >> 1] = pk2(VEL(xa, e) * (VEL(yr[n], e) + z.x * d1), VEL(xa, e + 1) * (VEL(yr[n], e + 1) + z.z * d1));
                oB[e >> 1] = pk2(VEL(xb, e) * (VEL(yi[n], e) + z.y * d1), VEL(xb, e + 1) * (VEL(yi[n], e + 1) + z.w * d1)); }
            *(u32x4v*)(hyo + (ov + mA + (unsigned)t0)) = oA; *(u32x4v*)(hyo + (ov + mB + (unsigned)t0)) = oB; } }
}
__device__ __forceinline__ void hyena_item(const int L, int c, int m_base, int nb, const float* FT, const HyParams& P, float* Kf, LAS unsigned char* lds) {
    const int N = 2 * L;
    LAS cf* X = (LAS cf*)lds; LAS float* coef = (LAS float*)(lds + LDS_COEF); LAS float* red = (LAS float*)(lds + LDS_RED);
    int tid = threadIdx.x; asm volatile("" : "+v"(tid));
    f32x4* K0 = (f32x4*)Kf; f32x4* K1 = (f32x4*)Kf + 8192; float* k1s = (float*)K1; f32x4* ZS = (f32x4*)Kf + 16384;
    __syncthreads();
    float s0 = 0.f, s1 = 0.f;
    const unsigned r00 = (unsigned)c * (unsigned)L, r01 = (unsigned)(1024 + c) * (unsigned)L, r10 = (unsigned)(2048 + c) * (unsigned)L, r11 = (unsigned)(3072 + c) * (unsigned)L;
#pragma unroll 2
    for (int j = 0; j < (L >> 11); ++j) { const int t0 = 4 * (tid + NTHR * j);
        const f32x4 fw0 = *(const f32x4*)(FT + (r00 + (unsigned)t0)), fw1 = *(const f32x4*)(FT + (r01 + (unsigned)t0));
        const f32x4 bw0 = *(const f32x4*)(FT + (r10 + (unsigned)t0)), bw1 = *(const f32x4*)(FT + (r11 + (unsigned)t0));
#pragma unroll
        for (int e = 0; e < 4; ++e) { const int t = t0 + e;
            s0 += fabsf(fw0[e]) + (t > 0 ? fabsf(bw0[e]) : 0.f); s1 += fabsf(fw1[e]) + (t > 0 ? fabsf(bw1[e]) : 0.f);
            if (t > 0) xst(X, N - t, cf{bw0[e], bw1[e]}); }
        *(LAS f32x4*)(X + fphys(t0)) = (f32x4){fw0[0], fw1[0], fw0[1], fw1[1]}; *(LAS f32x4*)(X + fphys(t0 + 2)) = (f32x4){fw0[2], fw1[2], fw0[3], fw1[3]}; }
    if (tid == 0) xst(X, L, cf{0.f, 0.f});
    s0 = block_sum(s0, red); s1 = block_sum(s1, red);
    const float sc0 = 1.0f / (s0 * (float)N), sc1 = 1.0f / (s1 * (float)N);
    __syncthreads();
    fft_fwd_head(X, N);
    stage16_last_inplace(X, N);
    __syncthreads();
    split_store(X, N, K0, K1);
    __syncthreads();
    const float wv0 = P.conv_w[c], wv1 = P.conv_w[NHY + c], wv2 = P.conv_w[2 * NHY + c], bv = P.conv_b[c];
    const float wa0 = P.conv_w[DH + c], wa1 = P.conv_w[NHY + DH + c], wa2 = P.conv_w[2 * NHY + DH + c], ba = P.conv_b[DH + c];
    const float wb0 = P.conv_w[2 * DH + c], wb1 = P.conv_w[NHY + 2 * DH + c], wb2 = P.conv_w[2 * NHY + 2 * DH + c], bb = P.conv_b[2 * DH + c];
    const float d0 = P.hbias[c], d1 = P.hbias[DH + c];
    const bf16_t* hyT = P.hyT; bf16_t* hyo = P.hyo;
    const unsigned ov = (unsigned)c * (unsigned)M_ALL, oa = (unsigned)(DH + c) * (unsigned)M_ALL, ob = (unsigned)(2 * DH + c) * (unsigned)M_ALL;
#pragma unroll 1
    for (int pr = 0; pr < nb / 2; ++pr) {
        const unsigned mA = (unsigned)(m_base + (2 * pr) * L), mB = mA + (unsigned)L;
        if (N == 16384) hy_pair<4>(X, N, L, tid, mA, mB, hyT, hyo, ov, oa, ob, K0, K1, ZS, sc0, sc1, d0, d1, wv0, wv1, wv2, bv, wa0, wa1, wa2, ba, wb0, wb1, wb2, bb);
        else hy_pair<2>(X, N, L, tid, mA, mB, hyT, hyo, ov, oa, ob, K0, K1, ZS, sc0, sc1, d0, d1, wv0, wv1, wv2, bv, wa0, wa1, wa2, ba, wb0, wb1, wb2, bb);
    }
}
constexpr int N_PHASES = 13;
__global__ void __launch_bounds__(NTHR, 2) fwd_kernel(Args args) {
    extern __shared__ __attribute__((aligned(16))) unsigned char lds_raw[];
    LAS unsigned char* lds = (LAS unsigned char*)lds_raw;
    const int tid = threadIdx.x, lane = tid & 63, wave = __builtin_amdgcn_readfirstlane(tid >> 6);
    const int G = gridDim.x, bx = blockIdx.x;
    const int vcu = (G % 8 == 0) ? (bx % 8) * (G / 8) + bx / 8 : bx;
    const int gw = vcu * NWAVES + wave, NGW = G * NWAVES;
    unsigned char* ws = args.ws;
    const float* x_p = args.in[0]; const float* x_s = args.in[1];
    const float* ffn1_norm = args.in[2]; const float* ffn1_w13 = args.in[3]; const float* ffn1_w2 = args.in[4];
    const float* mix_norm = args.in[5]; const float* w_in = args.in[6]; const float* q_norm = args.in[7]; const float* k_norm = args.in[8];
    const float* conv_w = args.in[9]; const float* conv_b = args.in[10];
    const float* filt_w1 = args.in[11]; const float* filt_b1 = args.in[12]; const float* filt_w2 = args.in[13]; const float* filt_b2 = args.in[14];
    const float* filt_w3 = args.in[15]; const float* filt_freq = args.in[16]; const float* hy_decay = args.in[17]; const float* hy_bias = args.in[18];
    const float* gon = args.in[19]; const float* w_out = args.in[20];
    const float* ffn2_norm = args.in[21]; const float* ffn2_w13 = args.in[22]; const float* ffn2_w2 = args.in[23]; const float* final_norm = args.in[24];
    float* out = args.out;
    bf16_t* W13A = (bf16_t*)(ws + WS_W13A); bf16_t* W2A = (bf16_t*)(ws + WS_W2A); bf16_t* WIN = (bf16_t*)(ws + WS_WIN); bf16_t* WOUT = (bf16_t*)(ws + WS_WOUT);
    bf16_t* W13B = (bf16_t*)(ws + WS_W13B); bf16_t* W2B = (bf16_t*)(ws + WS_W2B);
    bf16_t* XN = (bf16_t*)(ws + WS_XN); bf16_t* ACT = (bf16_t*)(ws + WS_ACT);
    bf16_t* QKV = (bf16_t*)(ws + WS_QKV); bf16_t* HYT = (bf16_t*)(ws + WS_HYT); bf16_t* HYO = (bf16_t*)(ws + WS_HYO);
    bf16_t* XN2 = (bf16_t*)(ws + WS_XN2);
    float* FTS = (float*)(ws + WS_FTS); float* FTP = (float*)(ws + WS_FTP); bf16_t* H2B = (bf16_t*)(ws + WS_H2B); bf16_t* W3T = (bf16_t*)(ws + WS_W3T);
    float* KSP = (float*)(ws + WS_KSP) + (size_t)bx * (2 * (2 * 16384 + 8192));
    const int lo = args.ph_lo, hi = args.ph_hi;
#ifndef PH_MASK
#define PH_MASK 0x1fff
#endif
#ifndef DUP_MASK
#define DUP_MASK 0
#endif
#define REP(k) for (int rep_ = 0; rep_ < 1 + ((DUP_MASK >> (k)) & 1); ++rep_)
#define IN(k) (((PH_MASK >> (k)) & 1) && lo <= (k) && (k) < hi)
#if MK_ONE_LAUNCH
#define SEAM(k) do { if (IN(k) && IN((k) + 1)) { cg::this_grid().sync(); } } while (0)
#else
#define SEAM(k) do { } while (0)
#endif

    if (IN(0)) REP(0) {
        LAS float* scr = (LAS float*)(lds + wave * 16384);
        constexpr int I13 = (DM / 64) * (2 * DFF / 32), I2 = (DFF / 64) * (DM / 32), IIN = (DM / 64) * (NIN / 32), IOUT = (DM / 64) * (DM / 32);
        constexpr int NITEMS = 2 * I13 + 2 * I2 + IIN + IOUT;
        for (int it = gw; it < NITEMS; it += NGW) {
            int r = it;
            if (r < 2 * I13) { const bool b = r >= I13; if (b) r -= I13; const int nblk = 2 * DFF / 32, kb = r / nblk, nb = r % nblk;
                transpose_item(b ? ffn2_w13 : ffn1_w13, DM, 2 * DFF, b ? W13B : W13A, 64 * kb, 32 * nb, swiglu_row(32 * nb), scr, lane); continue; }
            r -= 2 * I13;
            if (r < 2 * I2) { const bool b = r >= I2; if (b) r -= I2; const int nblk = DM / 32, kb = r / nblk, nb = r % nblk;
                transpose_item(b ? ffn2_w2 : ffn1_w2, DFF, DM, b ? W2B : W2A, 64 * kb, 32 * nb, 32 * nb, scr, lane); continue; }
            r -= 2 * I2;
            if (r < IIN) { const int nblk = NIN / 32, kb = r / nblk, nb = r % nblk; const int n0 = 32 * nb;
                if (n0 < 1280) { const int hh = n0 >> 7, d0 = n0 & 127; transpose_item(w_in, DM, NIN, WIN, 64 * kb, n0, hh * 128 + (d0 & 64) + ((d0 & 63) >> 5), scr, lane, 2); }
                else transpose_item(w_in, DM, NIN, WIN, 64 * kb, n0, n0, scr, lane);
                continue; }
            r -= IIN;
            { const int nblk = DM / 32, kb = r / nblk, nb = r % nblk; transpose_item(w_out, DM, DM, WOUT, 64 * kb, 32 * nb, 32 * nb, scr, lane); }
        }
        for (int m = gw; m < M_ALL; m += NGW) rms_row_bf16(m < M_P ? x_p + (size_t)m * DM : x_s + (size_t)(m - M_P) * DM, ffn1_norm, XN + (size_t)m * DM, lane);
        for (int i = vcu * NTHR + tid; i < 3 * 160 * 64; i += G * NTHR) ((unsigned*)(ws + WS_PCNT))[i] = 0u;
        for (int t = gw; t < L_S + L_P; t += NGW) h2_row(t < L_S ? L_S : L_P, t < L_S ? t : t - L_S, H2B + (size_t)t * 256, filt_w1, filt_b1, filt_w2, filt_b2, filt_freq, lane);
        for (int i = vcu * NTHR + tid; i < 4096 * 256; i += G * NTHR) { const int j = i >> 8, k = i & 255; W3T[i] = k < 64 ? (bf16_t)f2bf(filt_w3[(size_t)k * 4096 + j]) : (bf16_t)0; }
    }
    SEAM(0);
    if (IN(1)) REP(1) {
        pg8::Gemm g{XN, W13A, M_ALL, 2 * DFF, DM}; pg8::StaticOrder S; S.init(M_ALL, 2 * DFF, G, bx);
        pg8::EpiSwiGLU E{ACT, DFF};
        pg8::gemm_phase<pg8::EpiSwiGLU, pg8::StaticOrder, true, true>(lds, g, S, E);
    }
    SEAM(1);
    float* PART = (float*)(ws + WS_PART); unsigned* PCNT = (unsigned*)(ws + WS_PCNT);
    if (IN(2)) {
        { pg8::Gemm g{ACT, W2A, M_ALL, DM, DFF}; pg8::PanelOrder S{bx};
            pg8::EpiRmsX E{x_p, x_s, M_P, out, XN, DM, 0.5f, mix_norm, PART, PCNT + 160 * 64, lds + LDS_COEF};
            pg8::gemm_phase<pg8::EpiRmsX, pg8::PanelOrder, true, true>(lds, g, S, E); }
    }
    SEAM(2);
    if (IN(3)) { pg8::Gemm g{W3T, H2B, 4096, L_S + L_P, 256}; pg8::StaticOrder S; S.init(4096, L_S + L_P, G, bx);
        pg8::EpiFilt E{FTS, FTP, hy_decay};
        pg8::gemm_phase<pg8::EpiFilt, pg8::StaticOrder, true, true>(lds, g, S, E); }
    if (IN(4)) {
        { pg8::Gemm g{XN, WIN, M_ALL, NQKV, DM}; pg8::StaticOrder S; S.init(M_ALL, NQKV, G, bx);
          pg8::EpiQKV E{QKV, NQKV, q_norm, k_norm, lds + 131072};
          pg8::gemm_phase<pg8::EpiQKV, pg8::StaticOrder, true, true>(lds, g, S, E); }
        { pg8::Gemm g{WIN + (size_t)NQKV * DM, XN, NHY, M_ALL, DM}; pg8::StaticOrder S; S.init(NHY, M_ALL, G, bx);
          pg8::EpiBf16 E{HYT, M_ALL};
          pg8::gemm_phase<pg8::EpiBf16, pg8::StaticOrder, true, true>(lds, g, S, E); }
    }
    SEAM(4);
#define ATTN_ALL_UNITS() do { __syncthreads(); \
          \
        float mq = fmaxf(fabsf(q_norm[lane]), fabsf(q_norm[lane + 64])), mk = fmaxf(fabsf(k_norm[lane]), fabsf(k_norm[lane + 64])); \
        _Pragma("unroll") for (int o_ = 1; o_ < 64; o_ <<= 1) { mq = fmaxf(mq, __shfl_xor(mq, o_)); mk = fmaxf(mk, __shfl_xor(mk, o_)); } \
        const float negb = fmaxf(-16.65f * mq * mk, -60.0f); \
          \
        _Pragma("unroll 1") for (int uu = vcu; uu < 1280; uu += G) { const bool smp = uu < 1024; const int u = smp ? uu : uu - 1024; \
            const int qb = smp ? (u & 31) : (u & 15), h = smp ? ((u >> 5) & 7) : ((u >> 4) & 7), b = smp ? (u >> 8) : (u >> 7); \
            const int Ls = smp ? L_S : L_P; const unsigned r0 = smp ? (unsigned)(M_P + b * L_S) : (unsigned)(b * L_P); \
            const bf16_t* kvb = QKV + (size_t)r0 * NQKV + 1024 + (h >> 2) * 128; \
            attn::attn_dense_body(QKV + (size_t)(r0 + qb * 256) * NQKV + h * 128, kvb, kvb + 256, XN + (size_t)(r0 + qb * 256) * DM + h * 128, Ls, (char*)lds_raw, negb); } } while (0)
    const bool attn_first = (vcu & 1) != 0;
    if (IN(6) && attn_first) ATTN_ALL_UNITS();
    if (IN(5)) {
        HyParams P{conv_w, conv_b, filt_w3, hy_decay, hy_bias, HYT, HYO};
        __syncthreads();
#pragma unroll 1
        for (int it = vcu; it < 2 * DH; it += G) { const bool smp = it < DH;
            hyena_item(smp ? L_S : L_P, smp ? it : it - DH, smp ? M_P : 0, smp ? 4 : 2, smp ? FTS : FTP, P, KSP, lds); }
    }
    if (IN(6) && !attn_first) ATTN_ALL_UNITS();
#undef ATTN_ALL_UNITS
    SEAM(6);
    if (IN(7)) {
        for (int m = gw; m < M_ALL; m += NGW) { bf16_t* row = XN + (size_t)m * DM;
            u32x4v v0 = *((const u32x4v*)row + lane), v1 = *((const u32x4v*)row + 64 + lane); float s = 0.f; float f[16];
#pragma unroll
            for (int j = 0; j < 4; ++j) { f[2 * j] = __uint_as_float(v0[j] << 16); f[2 * j + 1] = __uint_as_float(v0[j] & 0xffff0000u); f[8 + 2 * j] = __uint_as_float(v1[j] << 16); f[8 + 2 * j + 1] = __uint_as_float(v1[j] & 0xffff0000u); }
#pragma unroll
            for (int j = 0; j < 16; ++j) s += f[j] * f[j];
            const float rstd = 1.0f / sqrtf(wave_sum(s) * (1.f / DH) + EPS);
            const float* g0 = gon + 8 * lane; const float* g1 = gon + 512 + 8 * lane;
#pragma unroll
            for (int j = 0; j < 4; ++j) { v0[j] = pk2(f[2 * j] * rstd * g0[2 * j], f[2 * j + 1] * rstd * g0[2 * j + 1]); v1[j] = pk2(f[8 + 2 * j] * rstd * g1[2 * j], f[8 + 2 * j + 1] * rstd * g1[2 * j + 1]); }
            *((u32x4v*)row + lane) = v0; *((u32x4v*)row + 64 + lane) = v1; }
        LAS unsigned* T = (LAS unsigned*)lds;
        for (int tile = vcu; tile < M_ALL / 64; tile += G) { const int m0 = tile * 64;
            __syncthreads();
            for (int i = 0; i < 16; ++i) { const int c = (tid >> 3) + 64 * i, ch = tid & 7; const u32x4v v = *(const u32x4v*)(HYO + (size_t)c * M_ALL + m0 + ch * 8);
                LAS unsigned* d = T + c * 33 + ch * 4; d[0] = v.x; d[1] = v.y; d[2] = v.z; d[3] = v.w; }
            __syncthreads();
            for (int tk = wave * 8; tk < wave * 8 + 8; ++tk) { float f[16]; float s = 0.f;
#pragma unroll
                for (int j = 0; j < 16; ++j) { const unsigned w = T[(lane + 64 * j) * 33 + (tk >> 1)]; f[j] = (tk & 1) ? __uint_as_float(w & 0xffff0000u) : __uint_as_float(w << 16); s += f[j] * f[j]; }
                const float rstd = 1.0f / sqrtf(wave_sum(s) * (1.f / DH) + EPS);
                bf16_t* orow = XN + (size_t)(m0 + tk) * DM + DH;
#pragma unroll
                for (int j = 0; j < 16; ++j) orow[lane + 64 * j] = (bf16_t)f2bf(f[j] * rstd * gon[DH + lane + 64 * j]); }
        }
    }
    SEAM(7);
    if (IN(8)) {
        { pg8::Gemm g{XN, WOUT, M_ALL, DM, DM}; pg8::PanelOrder S{bx};
            pg8::EpiRmsX E{out, out, 0, out, XN2, DM, 1.0f, ffn2_norm, PART, PCNT + 2 * 160 * 64, lds + LDS_COEF};
            pg8::gemm_phase<pg8::EpiRmsX, pg8::PanelOrder, true, true>(lds, g, S, E); }
    }
    SEAM(8);
    if (IN(10)) {
        pg8::Gemm g{XN2, W13B, M_ALL, 2 * DFF, DM}; pg8::StaticOrder S; S.init(M_ALL, 2 * DFF, G, bx);
        pg8::EpiSwiGLU E{ACT, DFF};
        pg8::gemm_phase<pg8::EpiSwiGLU, pg8::StaticOrder, true, true>(lds, g, S, E);
    }
    SEAM(10);
    if (IN(11)) {
        pg8::Gemm g{ACT, W2B, M_ALL, DM, DFF}; pg8::PanelOrder S{bx};
        pg8::EpiRmsFinal E{out, out, DM, 0.5f, final_norm, PART, PCNT, lds + LDS_COEF};
        pg8::gemm_phase<pg8::EpiRmsFinal, pg8::PanelOrder, true, true>(lds, g, S, E);
    }
#undef IN
#undef SEAM
}

extern "C" void kernel_launch(void* const* d_in, const int* in_sizes, int n_in, void* d_out, int out_size, void* d_ws, size_t ws_size, hipStream_t stream) {
    static int grid = 0;
    if (grid == 0) {
        if (n_in != 25 || out_size != M_ALL * DM || ws_size < WS_END) { fprintf(stderr, "kernel_launch: unexpected shapes n_in %d out %d ws %zu\n", n_in, out_size, ws_size); grid = -1; return; }
        int dev = 0, cus = 0, per_cu = 0;
        hipGetDevice(&dev); hipDeviceGetAttribute(&cus, hipDeviceAttributeMultiprocessorCount, dev);
        if (hipFuncSetAttribute((const void*)fwd_kernel, hipFuncAttributeMaxDynamicSharedMemorySize, LDS_BYTES) != hipSuccess) { fprintf(stderr, "kernel_launch: hipFuncSetAttribute failed\n"); grid = -1; return; }
        if (hipOccupancyMaxActiveBlocksPerMultiprocessor(&per_cu, (const void*)fwd_kernel, NTHR, LDS_BYTES) != hipSuccess || per_cu < 1) { fprintf(stderr, "kernel_launch: occupancy query says %d\n", per_cu); per_cu = 1; }
        (void)hipGetLastError();
        grid = cus * 1;
        if (grid != 256) { fprintf(stderr, "kernel_launch: this kernel is built for a 256-CU device (got %d CUs); nothing launched\n", cus); grid = -1; return; }
        fprintf(stderr, "kernel_launch: grid %d (cus %d, per_cu %d)\n", grid, cus, per_cu);
    }
    if (grid < 0) return;
    Args a{};
    for (int i = 0; i < 25; ++i) a.in[i] = (const float*)d_in[i];
    a.out = (float*)d_out; a.ws = (unsigned char*)d_ws;
#if MK_ONE_LAUNCH
    a.ph_lo = 0; a.ph_hi = N_PHASES;
    void* kargs[] = {&a};
    hipError_t e = hipLaunchCooperativeKernel((const void*)fwd_kernel, dim3(grid), dim3(NTHR), kargs, LDS_BYTES, stream);
    if (e != hipSuccess) fprintf(stderr, "kernel_launch: cooperative launch failed: %s (grid %d)\n", hipGetErrorString(e), grid);
#else
    for (int p = 0; p < N_PHASES; ++p) { a.ph_lo = p; a.ph_hi = p + 1;
        hipLaunchKernelGGL(fwd_kernel, dim3(grid), dim3(NTHR), LDS_BYTES, stream, a);
        const hipError_t le = hipPeekAtLastError(); if (le != hipSuccess) { fprintf(stderr, "kernel_launch: launch %d failed: %s\n", p, hipGetErrorName(le)); break; } }
#endif
}
```
